# Optimizing an MI355X kernel written in HIP

```python
import jax, jax.numpy as jnp
from jax import lax
import numpy as np

D_MODEL = 2048
BATCH = 2
SEQ = 4096
DEPTH = 1

GRID_W = 64
CTX_LEN = 256
D_A = 2048
D_B = 2048
D_MIX = D_A + D_B
N_BLOCKS_A = 16
BLOCK_A = D_A // N_BLOCKS_A
CONV_W = 4
CONV_PAD_L = 2
CONV_PAD_R = CONV_W - 1 - CONV_PAD_L
LRU_C = 8.0
N_HEADS_B = 16
HEAD_B = D_B // N_HEADS_B
CHUNK = 64
EPS = 1e-6
SPLITS = (D_A, 2 * D_A, 2 * D_A + D_B, 2 * D_A + 2 * D_B, 2 * D_A + 3 * D_B, 2 * D_A + 4 * D_B)
IN_COLS = 2 * D_A + 5 * D_B

kernel_name = "hybrid_rglru_hgrn2_dit_layer"


def rmsnorm(x, w):
    xf = x.astype(jnp.float32)
    y = xf * lax.rsqrt(jnp.mean(xf * xf, axis=-1, keepdims=True) + EPS)
    return (y * w.astype(jnp.float32)).astype(x.dtype)


def flip(z):
    return jnp.flip(z, axis=1)


def to_colmajor(z, rows):
    b, t, ch = z.shape
    return z.reshape(b, rows, GRID_W, ch).swapaxes(1, 2).reshape(b, t, ch)


def from_colmajor(z, rows):
    b, t, ch = z.shape
    return z.reshape(b, GRID_W, rows, ch).swapaxes(1, 2).reshape(b, t, ch)


def dwconv_centred(u, w, b):
    t = u.shape[1]
    up = jnp.pad(u, ((0, 0), (CONV_PAD_L, CONV_PAD_R), (0, 0)))
    return b + sum(up[:, k:k + t] * w[k] for k in range(CONV_W))


def linear_scan(a, b, h0):
    b = b.at[:, 0].add(a[:, 0] * h0)

    def comb(left, right):
        al, bl = left
        ar, br = right
        return ar * al, ar * bl + br

    _, h = lax.associative_scan(comb, (a, b), axis=1)
    return h


def rglru_scan(u, w_r, b_r, w_i, b_i, lam, h0):
    uf = u.astype(jnp.float32)
    ub = uf.reshape(uf.shape[0], uf.shape[1], N_BLOCKS_A, BLOCK_A)
    r = jax.nn.sigmoid(jnp.einsum('btnc,ncd->btnd', ub, w_r.astype(jnp.float32)).reshape(uf.shape) + b_r.astype(jnp.float32))
    i = jax.nn.sigmoid(jnp.einsum('btnc,ncd->btnd', ub, w_i.astype(jnp.float32)).reshape(uf.shape) + b_i.astype(jnp.float32))
    log_a = -LRU_C * r * jax.nn.softplus(-lam.astype(jnp.float32))
    a = jnp.exp(log_a)
    bx = jnp.sqrt(-jnp.expm1(2.0 * log_a)) * (i * uf)
    h = linear_scan(a, bx, h0)
    return h, h[:, -1]


def hgrn2_chunked(q, k, v, log_f, s0):
    bsz, t = q.shape[0], q.shape[1]
    n = t // CHUNK

    def chunks(z):
        return z.reshape(bsz, n, CHUNK, N_HEADS_B, HEAD_B).transpose(1, 0, 3, 2, 4)

    causal = jnp.tril(jnp.ones((CHUNK, CHUNK), dtype=bool))

    def step(s, inp):
        qc, kc, vc, gc = inp
        F = jnp.cumsum(gc, axis=2)
        diff = F[:, :, :, None, :] - F[:, :, None, :, :]
        decay = jnp.exp(jnp.where(causal[:, :, None], diff, -jnp.inf))
        scores = jnp.einsum('bhtk,bhsk,bhtsk->bhts', qc, kc, decay)
        o = jnp.einsum('bhts,bhsv->bhtv', scores, vc) + jnp.einsum('bhtk,bhkv->bhtv', qc * jnp.exp(F), s)
        f_last = F[:, :, -1]
        s_new = jnp.exp(f_last)[..., None] * s + jnp.einsum('bhsk,bhsv->bhkv', kc * jnp.exp(f_last[:, :, None] - F), vc)
        return s_new, o

    s_final, o = lax.scan(step, s0, (chunks(q), chunks(k), chunks(v), chunks(log_f)))
    o = o.transpose(1, 0, 3, 2, 4).reshape(bsz, t, N_HEADS_B, HEAD_B)
    return o, s_final


def hgrn2_dir(q, f_pre, v, lb, s0):
    f = lb + (1.0 - lb) * jax.nn.sigmoid(f_pre)
    return hgrn2_chunked(q, 1.0 - f, v, jnp.log(f), s0)


def split_heads(z):
    return z.astype(jnp.float32).reshape(z.shape[0], z.shape[1], N_HEADS_B, HEAD_B)


def hybrid_layer(x, ctx, c, c_ctx, rows, ada_w, ada_b, norm_w, w_in, conv_w, conv_b,
                 lru_wr, lru_br, lru_wi, lru_bi, lru_lambda, lb_f, lb_b, hgrn_norm_w, w_out, last):
    bsz, t = x.shape[0], x.shape[1]
    shift, scale, gate = jnp.split(jax.nn.silu(c) @ ada_w + ada_b, 3, axis=-1)
    shift_c, scale_c, gate_c = jnp.split(jax.nn.silu(c_ctx) @ ada_w + ada_b, 3, axis=-1)
    h_lat = rmsnorm(x, norm_w) * (1.0 + scale[:, None]) + shift[:, None]
    h_ctx = rmsnorm(ctx, norm_w) * (1.0 + scale_c) + shift_c
    xa_l, ga_l, q_l, ff_l, fb_l, v_l, gb_l = jnp.split(h_lat @ w_in, SPLITS, axis=-1)
    xa_c, ga_c, q_c, ff_c, fb_c, v_c, gb_c = jnp.split(h_ctx @ w_in, SPLITS, axis=-1)

    ua_l = dwconv_centred(xa_l, conv_w, conv_b)
    ua_c = dwconv_centred(xa_c, conv_w, conv_b)
    p_fwd = (lru_wr[0], lru_br[0], lru_wi[0], lru_bi[0], lru_lambda[0])
    p_bwd = (lru_wr[1], lru_br[1], lru_wi[1], lru_bi[1], lru_lambda[1])
    h0 = jnp.zeros((bsz, D_A), jnp.float32)
    hc_f, sc_f = rglru_scan(ua_c, *p_fwd, h0)
    hl_f, _ = rglru_scan(ua_l, *p_fwd, sc_f)
    hc_b, sc_b = rglru_scan(flip(ua_c), *p_bwd, h0)
    hl_b, _ = rglru_scan(flip(ua_l), *p_bwd, sc_b)
    ya_l = (hl_f + flip(hl_b)).astype(x.dtype) * jax.nn.silu(ga_l)

    qL = jax.nn.silu(split_heads(to_colmajor(q_l, rows)))
    ffL, fbL, vL = [split_heads(to_colmajor(z, rows)) for z in (ff_l, fb_l, v_l)]
    qC = jax.nn.silu(split_heads(q_c))
    ffC, fbC, vC = [split_heads(z) for z in (ff_c, fb_c, v_c)]
    s0 = jnp.zeros((bsz, N_HEADS_B, HEAD_B, HEAD_B), jnp.float32)
    oc_f, Sc_f = hgrn2_dir(qC, ffC, vC, lb_f, s0)
    ol_f, _ = hgrn2_dir(qL, ffL, vL, lb_f, Sc_f)
    oc_b, Sc_b = hgrn2_dir(flip(qC), flip(fbC), flip(vC), lb_b, s0)
    ol_b, _ = hgrn2_dir(flip(qL), flip(fbL), flip(vL), lb_b, Sc_b)
    ol = from_colmajor((ol_f + flip(ol_b)).reshape(bsz, t, D_B), rows)
    ol = rmsnorm(ol.reshape(bsz, t, N_HEADS_B, HEAD_B), hgrn_norm_w).reshape(bsz, t, D_B)
    yb_l = ol.astype(x.dtype) * jax.nn.silu(gb_l)

    x = x + gate[:, None] * (jnp.concatenate([ya_l, yb_l], axis=-1) @ w_out)

    if not last:
        ya_c = (hc_f + flip(hc_b)).astype(ctx.dtype) * jax.nn.silu(ga_c)
        oc = rmsnorm(oc_f + flip(oc_b), hgrn_norm_w).reshape(bsz, ctx.shape[1], D_B)
        yb_c = oc.astype(ctx.dtype) * jax.nn.silu(gb_c)
        ctx = ctx + gate_c * (jnp.concatenate([ya_c, yb_c], axis=-1) @ w_out)
    return x, ctx


def setup_inputs(seed: int = 0) -> dict:
    key = jax.random.key(seed)
    ks = jax.random.split(key, 20)
    f32 = jnp.float32
    nrm = lambda k, shape, s: jax.random.normal(k, shape, f32) * s
    u = jax.random.uniform(ks[14], (DEPTH, 2, D_A), f32, 0.9, 0.999)
    a = u ** (1.0 / LRU_C)
    lru_lambda = jnp.log(a) - jnp.log1p(-a)
    return {
        "x": nrm(ks[0], (BATCH, SEQ, D_MODEL), 1.0),
        "c": nrm(ks[1], (BATCH, D_MODEL), 1.0),
        "ctx": nrm(ks[2], (BATCH, CTX_LEN, D_MODEL), 1.0),
        "c_ctx": nrm(ks[3], (D_MODEL,), 1.0),
        "ada_w": nrm(ks[4], (DEPTH, D_MODEL, 3 * D_MODEL), 0.5 * D_MODEL ** -0.5),
        "ada_b": nrm(ks[5], (DEPTH, 3 * D_MODEL), 0.01),
        "norm_w": 1.0 + nrm(ks[6], (DEPTH, D_MODEL), 0.02),
        "w_in": nrm(ks[7], (DEPTH, D_MODEL, IN_COLS), D_MODEL ** -0.5),
        "conv_w": nrm(ks[8], (DEPTH, CONV_W, D_A), CONV_W ** -0.5),
        "conv_b": nrm(ks[9], (DEPTH, D_A), 0.01),
        "lru_wr": nrm(ks[10], (DEPTH, 2, N_BLOCKS_A, BLOCK_A, BLOCK_A), BLOCK_A ** -0.5),
        "lru_br": nrm(ks[11], (DEPTH, 2, D_A), 0.01),
        "lru_wi": nrm(ks[12], (DEPTH, 2, N_BLOCKS_A, BLOCK_A, BLOCK_A), BLOCK_A ** -0.5),
        "lru_bi": nrm(ks[13], (DEPTH, 2, D_A), 0.01),
        "lru_lambda": lru_lambda,
        "hgrn_lb_logits": nrm(ks[15], (2, DEPTH + 1, D_B), 0.5),
        "hgrn_norm_w": 1.0 + nrm(ks[16], (DEPTH, HEAD_B), 0.02),
        "w_out": nrm(ks[17], (DEPTH, D_MIX, D_MODEL), D_MIX ** -0.5),
        "final_norm_w": 1.0 + nrm(ks[18], (D_MODEL,), 0.02),
    }


def reference(x, c, ctx, c_ctx, ada_w, ada_b, norm_w, w_in, conv_w, conv_b,
              lru_wr, lru_br, lru_wi, lru_bi, lru_lambda, hgrn_lb_logits, hgrn_norm_w,
              w_out, final_norm_w):
    rows = x.shape[1] // GRID_W
    lb_all = jnp.cumsum(jax.nn.softmax(hgrn_lb_logits.astype(jnp.float32), axis=1), axis=1)
    for l in range(DEPTH):
        x, ctx = hybrid_layer(
            x, ctx, c, c_ctx, rows, ada_w[l], ada_b[l], norm_w[l], w_in[l], conv_w[l], conv_b[l],
            lru_wr[l], lru_br[l], lru_wi[l], lru_bi[l], lru_lambda[l],
            lb_all[0, l].reshape(N_HEADS_B, HEAD_B), lb_all[1, l].reshape(N_HEADS_B, HEAD_B),
            hgrn_norm_w[l], w_out[l], l == DEPTH - 1)
    return rmsnorm(x, final_norm_w)
```

```cpp
#include <hip/hip_runtime.h>
#include <hip/hip_cooperative_groups.h>
#include <cstdio>
#include <cstdint>

#ifndef MK_N_LAUNCHES
#define MK_N_LAUNCHES 6
#endif

namespace pg8 {
#define PG8_LAS __attribute__((address_space(3)))
typedef unsigned short bf16_t;
typedef short bf16x8 __attribute__((ext_vector_type(8)));
typedef float f32x4 __attribute__((ext_vector_type(4)));
typedef unsigned u32x4 __attribute__((ext_vector_type(4)));
constexpr int BM = 256, BK = 64, HALF = 128, HTB = HALF * BK * 2, STAGE_BYTES = 8 * HTB, NXCD = 8, WGM = 8;

__host__ __device__ __forceinline__ int lds_byte(int r, int c) { const int st = (r >> 4) * 2 + (c >> 5), rr = r & 15, cc = c & 31, ob = rr * 64 + cc * 2; return st * 1024 + (ob ^ (((ob >> 9) & 1) << 5)); }
__host__ __device__ __forceinline__ void stage_rc(int b, int& R, int& C) { const int st = b / 1024, sb = b % 1024, swz = sb ^ (((sb >> 9) & 1) << 5); R = (st >> 1) * 16 + swz / 64; C = (st & 1) * 32 + (swz % 64) / 2; }
__host__ __device__ __forceinline__ int perm32(int rho) { const int n = rho >> 4, i = rho & 15; return 8 * (i >> 2) + 4 * n + (i & 3); }

struct Unit { int pm, pn; };
struct Gemm { const bf16_t* A; const bf16_t* Bt; int M, N, K; };

__device__ __forceinline__ unsigned cvt_pk_bf16(float lo, float hi) { unsigned r; asm volatile("v_cvt_pk_bf16_f32 %0, %1, %2" : "=v"(r) : "v"(lo), "v"(hi)); return r; }

template <class Epi, class Sched, bool ALIGN_EPI = false, bool SP2 = false>
__device__ __forceinline__ void gemm_phase(PG8_LAS unsigned char* lds, const Gemm g, const Sched& S, const Epi& E) {
    const int tid = threadIdx.x, wid = __builtin_amdgcn_readfirstlane(tid >> 6), lane = tid & 63, wr = wid >> 2, wc = wid & 3, fr = lane & 15, fq = lane >> 4;
    const int K = g.K, nt = K / BK;
    unsigned voffA[2], voffB[2];
#pragma unroll
    for (int i = 0; i < 2; ++i) { int R, C; stage_rc(tid * 16 + i * 8192, R, C); const int Rb = Epi::PERM ? ((R & ~31) + perm32(R & 31)) : R;
        voffA[i] = (unsigned)(R * K + C) * 2u; voffB[i] = (unsigned)(Rb * K + C) * 2u; }
    const size_t kstep = (size_t)(BK * 2);
    const size_t hstep = (size_t)HALF * K * 2;
    const size_t tstep = 2 * hstep;
    const unsigned ldsw = (unsigned)wid * 1024u;
    const int aoff = lds_byte(wr * 64 + fr, fq * 8), boff = lds_byte(wc * 32 + fr, fq * 8);
#define PG8_SA(b, h) (((b) * 2 + (h)) * HTB)
#define PG8_SB(b, h) ((4 + (b) * 2 + (h)) * HTB)
#define PG8_STAGE(bufoff, gbase, voff) do { _Pragma("unroll") for (int _i = 0; _i < 2; ++_i) \
        __builtin_amdgcn_global_load_lds((const unsigned*)((const char*)(gbase) + (voff)[_i]), (PG8_LAS unsigned*)(lds + (bufoff) + ldsw + _i * 8192), 16, 0, 0); } while (0)
#define PG8_LDA(dst, b, h) do { _Pragma("unroll") for (int m = 0; m < 4; ++m) _Pragma("unroll") for (int k = 0; k < 2; ++k) dst[m][k] = *(const PG8_LAS bf16x8*)(lds + PG8_SA(b, h) + aoff + m * 2048 + k * 1024); } while (0)
#define PG8_LDB(dst, b, h) do { _Pragma("unroll") for (int n = 0; n < 2; ++n) _Pragma("unroll") for (int k = 0; k < 2; ++k) dst[n][k] = *(const PG8_LAS bf16x8*)(lds + PG8_SB(b, h) + boff + n * 2048 + k * 1024); } while (0)
#define PG8_MMA(ai, bj, At, Bt) do { __builtin_amdgcn_s_setprio(1); _Pragma("unroll") for (int m = 0; m < 4; ++m) _Pragma("unroll") for (int n = 0; n < 2; ++n) _Pragma("unroll") for (int k = 0; k < 2; ++k) \
        acc[ai][bj][m][n] = __builtin_amdgcn_mfma_f32_16x16x32_bf16(Bt[n][k], At[m][k], acc[ai][bj][m][n], 0, 0, 0); __builtin_amdgcn_s_setprio(0); } while (0)
#define PG8_WAIT_V(n) asm volatile("s_waitcnt vmcnt(" #n ")" ::: "memory")
#define PG8_WAIT_L(n) asm volatile("s_waitcnt lgkmcnt(" #n ")" ::: "memory")
#define PG8_BAR __builtin_amdgcn_s_barrier()
#define PG8_SCHED __builtin_amdgcn_sched_barrier(0)
    Unit cur, nxt; int ui = 0;
    if (!S.next(0, cur)) return;
    f32x4 acc[2][2][4][2];
#pragma unroll
    for (int a = 0; a < 2; ++a)
#pragma unroll
        for (int b = 0; b < 2; ++b)
#pragma unroll
            for (int m = 0; m < 4; ++m)
#pragma unroll
                for (int n = 0; n < 2; ++n) acc[a][b][m][n] = (f32x4){0.f, 0.f, 0.f, 0.f};
    bf16x8 At[4][2], B0[2][2], B1[2][2];
    const char* cA = (const char*)g.A + (size_t)cur.pm * tstep; const char* cB = (const char*)g.Bt + (size_t)cur.pn * tstep;
    S.a_ready(cur);
    if constexpr (SP2) {
        PG8_STAGE(PG8_SB(0, 0), cB, voffB); PG8_STAGE(PG8_SB(0, 1), cB + hstep, voffB); PG8_STAGE(PG8_SA(0, 0), cA, voffA); PG8_STAGE(PG8_SA(0, 1), cA + hstep, voffA);
        if (wr == 1) PG8_BAR;
        PG8_WAIT_V(2); PG8_BAR;
        PG8_STAGE(PG8_SB(1, 0), cB + kstep, voffB); PG8_STAGE(PG8_SA(1, 0), cA + kstep, voffA); PG8_STAGE(PG8_SB(1, 1), cB + hstep + kstep, voffB);
        PG8_WAIT_V(6); PG8_BAR;
    } else {
        PG8_STAGE(PG8_SB(0, 0), cB, voffB); PG8_STAGE(PG8_SA(0, 0), cA, voffA); PG8_STAGE(PG8_SB(0, 1), cB + hstep, voffB); PG8_STAGE(PG8_SA(0, 1), cA + hstep, voffA);
        if (wr == 1) PG8_BAR;
        PG8_WAIT_V(4); PG8_BAR;
        PG8_STAGE(PG8_SB(1, 0), cB + kstep, voffB); PG8_STAGE(PG8_SA(1, 0), cA + kstep, voffA); PG8_STAGE(PG8_SB(1, 1), cB + hstep + kstep, voffB);
        PG8_WAIT_V(6); PG8_BAR;
    }
    for (;;) {
        const bool has_next = S.next(ui + 1, nxt);
        const char* nA = has_next ? (const char*)g.A + (size_t)nxt.pm * tstep : cA; const char* nB = has_next ? (const char*)g.Bt + (size_t)nxt.pn * tstep : cB;
        for (int t = 0; t < nt; t += 2) {
            const bool last = (t == nt - 2);
            const char* a1 = cA + (size_t)(t + 1) * kstep;
            const char* a2 = last ? nA : cA + (size_t)(t + 2) * kstep; const char* b2 = last ? nB : cB + (size_t)(t + 2) * kstep;
            const char* a3 = a2 + kstep; const char* b3 = b2 + kstep;
            if (last && has_next) S.a_ready(nxt);
            if constexpr (SP2) {
            PG8_LDB(B0, 0, 0); PG8_LDB(B1, 0, 1); PG8_SCHED; PG8_LDA(At, 0, 0); PG8_STAGE(PG8_SA(1, 1), a1 + hstep, voffA);
            PG8_WAIT_V(8); PG8_WAIT_L(0); PG8_BAR; PG8_MMA(0, 0, At, B0); PG8_MMA(0, 1, At, B1); PG8_BAR; PG8_SCHED;
            PG8_LDA(At, 0, 1); PG8_STAGE(PG8_SB(0, 0), b2, voffB); PG8_STAGE(PG8_SB(0, 1), b2 + hstep, voffB); PG8_STAGE(PG8_SA(0, 0), a2, voffA);
            PG8_WAIT_V(8); PG8_WAIT_L(0); PG8_BAR; PG8_MMA(1, 0, At, B0); PG8_MMA(1, 1, At, B1); PG8_BAR; PG8_SCHED;
            PG8_LDB(B0, 1, 0); PG8_LDB(B1, 1, 1); PG8_SCHED; PG8_LDA(At, 1, 0); PG8_STAGE(PG8_SA(0, 1), a2 + hstep, voffA);
            PG8_WAIT_V(8); PG8_WAIT_L(0); PG8_BAR; PG8_MMA(0, 0, At, B0); PG8_MMA(0, 1, At, B1); PG8_BAR; PG8_SCHED;
            PG8_LDA(At, 1, 1); PG8_STAGE(PG8_SB(1, 0), b3, voffB); PG8_STAGE(PG8_SB(1, 1), b3 + hstep, voffB); PG8_STAGE(PG8_SA(1, 0), a3, voffA);
            PG8_WAIT_V(8); PG8_WAIT_L(0); PG8_BAR; PG8_MMA(1, 0, At, B0); PG8_MMA(1, 1, At, B1); PG8_BAR; PG8_SCHED;
            } else {
            PG8_LDB(B0, 0, 0); PG8_SCHED; PG8_LDA(At, 0, 0); PG8_STAGE(PG8_SA(1, 1), a1 + hstep, voffA);
            PG8_WAIT_L(8); PG8_BAR; PG8_WAIT_L(0); PG8_MMA(0, 0, At, B0); PG8_BAR; PG8_SCHED;
            PG8_LDB(B1, 0, 1); PG8_STAGE(PG8_SB(0, 0), b2, voffB);
            PG8_BAR; PG8_WAIT_L(0); PG8_MMA(0, 1, At, B1); PG8_BAR;
            PG8_LDA(At, 0, 1); PG8_STAGE(PG8_SA(0, 0), a2, voffA);
            PG8_BAR; PG8_WAIT_L(0); PG8_MMA(1, 0, At, B0); PG8_BAR; PG8_SCHED;
            PG8_STAGE(PG8_SB(0, 1), b2 + hstep, voffB);
            PG8_WAIT_V(6); PG8_BAR; PG8_MMA(1, 1, At, B1); PG8_BAR;
            PG8_LDB(B0, 1, 0); PG8_SCHED; PG8_LDA(At, 1, 0); PG8_STAGE(PG8_SA(0, 1), a2 + hstep, voffA);
            PG8_WAIT_L(8); PG8_BAR; PG8_WAIT_L(0); PG8_MMA(0, 0, At, B0); PG8_BAR; PG8_SCHED;
            PG8_LDB(B1, 1, 1); PG8_STAGE(PG8_SB(1, 0), b3, voffB);
            PG8_BAR; PG8_WAIT_L(0); PG8_MMA(0, 1, At, B1); PG8_BAR;
            PG8_LDA(At, 1, 1); PG8_STAGE(PG8_SA(1, 0), a3, voffA);
            PG8_BAR; PG8_WAIT_L(0); PG8_MMA(1, 0, At, B0); PG8_BAR; PG8_SCHED;
            PG8_STAGE(PG8_SB(1, 1), b3 + hstep, voffB);
            PG8_WAIT_V(6); PG8_BAR; PG8_MMA(1, 1, At, B1); PG8_BAR;
            }
        }
        if constexpr (ALIGN_EPI) { if (wr == 0) PG8_BAR; }
        E(acc, cur, wr, wc, fr, fq); S.done(cur);
        if (!has_next) break;
#pragma unroll
        for (int a = 0; a < 2; ++a)
#pragma unroll
            for (int b = 0; b < 2; ++b)
#pragma unroll
                for (int m = 0; m < 4; ++m)
#pragma unroll
                    for (int n = 0; n < 2; ++n) acc[a][b][m][n] = (f32x4){0.f, 0.f, 0.f, 0.f};
        cur = nxt; cA = nA; cB = nB; ++ui;
        if constexpr (ALIGN_EPI) { if (wr == 1) PG8_BAR; }
    }
    PG8_WAIT_V(0);
    if constexpr (!ALIGN_EPI) { if (wr == 0) PG8_BAR; }
    PG8_BAR;
#undef PG8_SA
#undef PG8_SB
#undef PG8_STAGE
#undef PG8_LDA
#undef PG8_LDB
#undef PG8_MMA
#undef PG8_WAIT_V
#undef PG8_WAIT_L
#undef PG8_BAR
#undef PG8_SCHED
}
}

constexpr int NWAVES = 8, NTHR = 512;
constexpr int DM = 2048, SEQ = 4096, CTXL = 256, NBATCH = 2, TT = CTXL + SEQ;
constexpr int MLAT = NBATCH * SEQ, MCTX = NBATCH * CTXL, MTOT = MLAT + MCTX;
constexpr int INC = 7 * DM;
constexpr int DMIX = 2 * DM;
constexpr float EPS = 1e-6f;
constexpr int NPHASE = 6;

constexpr size_t MiB = 1u << 20;
constexpr size_t WS_CTL = 0, CTL_ZERO_BYTES = 1 * MiB;
constexpr size_t WS_MOD = 1 * MiB;
constexpr size_t WS_WOUT = 4 * MiB;
constexpr size_t WS_WIN = 20 * MiB;
constexpr size_t WS_H = 76 * MiB;
constexpr size_t WS_XA = 110 * MiB;
constexpr size_t WS_FF = 144 * MiB;
constexpr size_t WS_FB = 178 * MiB;
constexpr size_t WS_V = 212 * MiB;
constexpr size_t WS_GA = 246 * MiB;
constexpr size_t WS_Q = 278 * MiB;
constexpr size_t WS_GB = 310 * MiB;
constexpr size_t WS_Y = 342 * MiB;
constexpr size_t WS_TMPA = 20 * MiB;
constexpr size_t WS_TMPB = 52 * MiB;
constexpr size_t WS_END = 406 * MiB;

constexpr int CW_BAR = 4096;

constexpr int RING_BYTES = 131072;
constexpr int LDSCTL_OFF = RING_BYTES, MISC_OFF = LDSCTL_OFF + 320;
constexpr int LDS_BYTES = 147456;

#define GAS __attribute__((address_space(1)))
#define LAS __attribute__((address_space(3)))
typedef unsigned short bf16;
typedef unsigned v4u __attribute__((ext_vector_type(4)));
typedef unsigned v2u __attribute__((ext_vector_type(2)));
typedef float f32x4 __attribute__((ext_vector_type(4)));
#define LDS_WAIT() asm volatile("s_waitcnt lgkmcnt(0)" ::: "memory")
#define VM_WAIT() asm volatile("s_waitcnt vmcnt(0)" ::: "memory")
__device__ __forceinline__ unsigned f2bf(float f) { unsigned u = __builtin_bit_cast(unsigned, f); return (u + 0x7fffu + ((u >> 16) & 1u)) >> 16; }
__device__ __forceinline__ unsigned pk2(float lo, float hi) { return f2bf(lo) | (f2bf(hi) << 16); }
__device__ __forceinline__ float bf2f(bf16 b) { return __builtin_bit_cast(float, ((unsigned)b) << 16); }
__device__ __forceinline__ float sigmoidf_(float x) { return 1.0f / (1.0f + __expf(-x)); }
__device__ __forceinline__ float siluf_(float x) { return x / (1.0f + __expf(-x)); }

#define XB_TMO      128
#define XB_XCNT(j)  (256  + 64 * (j))
#define XB_XSUB(j)  (1280 + 64 * (j))
#define XB_XGEN(j)  (2304 + 64 * (j))
#define XB_TOP      3328
#define XB_TOPGEN   3392
#define XCD_BAR_WORDS 3456
#define XB_SPIN_CAP (1u << 18)
__device__ __forceinline__ unsigned xb_ld(unsigned* p)              { return __hip_atomic_load(p, __ATOMIC_RELAXED, __HIP_MEMORY_SCOPE_AGENT); }
__device__ __forceinline__ unsigned xb_add(unsigned* p, unsigned v) { return __hip_atomic_fetch_add(p, v, __ATOMIC_RELAXED, __HIP_MEMORY_SCOPE_AGENT); }
__device__ __forceinline__ unsigned xb_xcc_id() { return (unsigned)__builtin_amdgcn_s_getreg((3 << 11) | 20) & 0xFu; }
#define XB_SPIN(cond, bar) do { unsigned _sp = 0; while (cond) { __builtin_amdgcn_s_sleep(1); \
    if ((++_sp & 255u) == 0u) { if (xb_ld(&(bar)[XB_TMO])) break; if (_sp > XB_SPIN_CAP) { atomicAdd(&(bar)[XB_TMO], 1u); break; } } } } while (0)
struct XcdBarrier { unsigned* bar; unsigned x; volatile LAS unsigned* st; };
__device__ __forceinline__ XcdBarrier xcd_barrier_post(unsigned* bar, volatile LAS unsigned* st) {
    XcdBarrier b; b.bar = bar; b.x = xb_xcc_id(); b.st = st;
    if (threadIdx.x == 0) (void)xb_add(&bar[XB_XCNT(b.x)], 1u);
    return b;
}
__device__ __forceinline__ void xcd_barrier_complete(unsigned* bar, unsigned x, unsigned& nloc, unsigned& nx) {
    const unsigned G = gridDim.x * gridDim.y * gridDim.z;
    unsigned sum, cnt, mine, sp = 0u;
    for (;;) {
        sum = 0u; cnt = 0u; mine = 0u;
#pragma unroll
        for (unsigned j = 0; j < 16; ++j) { const unsigned c = xb_ld(&bar[XB_XCNT(j)]); sum += c; cnt += (c > 0u) ? 1u : 0u; mine = (j == x) ? c : mine; }
        if (sum == G) break;
        __builtin_amdgcn_s_sleep(1);
        if ((++sp & 255u) == 0u) { if (xb_ld(&bar[XB_TMO])) break; if (sp > XB_SPIN_CAP) { atomicAdd(&bar[XB_TMO], 1u); break; } }
    }
    nloc = mine > 0u ? mine : 1u; nx = cnt > 0u ? cnt : 1u;
}
__device__ __forceinline__ void xcd_barrier(const XcdBarrier& b) {
    asm volatile("s_waitcnt vmcnt(0)" ::: "memory");
    __syncthreads();
    if (threadIdx.x == 0) {
        unsigned* bar = b.bar;
        __builtin_amdgcn_s_waitcnt(0);
        unsigned nloc = b.st[0], nx = b.st[1];
        if (nloc == 0u) { xcd_barrier_complete(bar, b.x, nloc, nx); b.st[0] = nloc; b.st[1] = nx; }
        const unsigned old = xb_add(&bar[XB_XSUB(b.x)], 1u);
        const unsigned gen = old / nloc;
        if (old + 1u == (gen + 1u) * nloc) {
            __builtin_amdgcn_fence(__ATOMIC_RELEASE, "agent");
            asm volatile("s_waitcnt vmcnt(0)" ::: "memory");
            const unsigned og = xb_add(&bar[XB_TOP], 1u);
            const unsigned tg = og / nx;
            if (og + 1u == (tg + 1u) * nx) xb_add(&bar[XB_TOPGEN], 1u);
            else XB_SPIN(xb_ld(&bar[XB_TOPGEN]) == tg, bar);
            __builtin_amdgcn_fence(__ATOMIC_ACQUIRE, "agent");
            xb_add(&bar[XB_XGEN(b.x)], 1u);
            asm volatile("s_waitcnt vmcnt(0)" ::: "memory");
        } else {
            XB_SPIN(xb_ld(&bar[XB_XGEN(b.x)]) == gen, bar);
            __builtin_amdgcn_fence(__ATOMIC_ACQUIRE, "agent");
            asm volatile("s_waitcnt vmcnt(0)" ::: "memory");
        }
    }
    __syncthreads();
}

struct Args {
    const float* in[19];
    float* out; unsigned char* ws;
    int ph_lo, ph_hi;
};
enum { I_X = 0, I_C, I_CTX, I_CCTX, I_ADAW, I_ADAB, I_NORMW, I_WIN, I_CONVW, I_CONVB, I_WR, I_BR, I_WI, I_BI, I_LAM, I_LB, I_HNW, I_WOUT, I_FNW };

__device__ __forceinline__ float wave_sum(float v) {
#pragma unroll
    for (int o = 1; o < 64; o <<= 1) v += __shfl_xor(v, o);
    return v;
}

__device__ __forceinline__ void p0_transpose_item(const float* W, int K, int N, bf16* WT, LAS float* scr, int item, int lane) {
    const int nblk = N / 32, kb = item / nblk, nb = item % nblk, k0 = 64 * kb, n0 = 32 * nb;
#pragma unroll 8
    for (int i = 0; i < 32; ++i) { const int kk = 2 * i + (lane >> 5); scr[kk * 33 + (lane & 31)] = W[(size_t)(k0 + kk) * N + n0 + (lane & 31)]; }
    LDS_WAIT(); asm volatile("" ::: "memory");
    const int c = lane & 7;
#pragma unroll
    for (int j = 0; j < 4; ++j) { const int n = (lane >> 3) + 8 * j; const LAS float* s = scr + (8 * c) * 33 + n;
        v4u o; o.x = pk2(s[0 * 33], s[1 * 33]); o.y = pk2(s[2 * 33], s[3 * 33]); o.z = pk2(s[4 * 33], s[5 * 33]); o.w = pk2(s[6 * 33], s[7 * 33]);
        *(GAS v4u*)(WT + (size_t)(n0 + n) * K + k0 + 8 * c) = o; }
    LDS_WAIT(); asm volatile("" ::: "memory");
}

struct Order1 {
    int G, c;
    __device__ __forceinline__ bool next(int i, pg8::Unit& u) const {
        const long L = (long)i * G + c; if (L >= 1856) return false;
        int wgid = (int)L; { const int xcd = wgid % 8, off = wgid / 8; wgid = xcd * 232 + off; }
        if (wgid < 1792) { const int g = wgid / 448, rem = wgid % 448; u.pm = g * 8 + (rem & 7); u.pn = rem >> 3; }
        else { const int w = wgid - 1792; u.pm = 32 + (w & 1); const int pi = w >> 1; u.pn = (pi < 8) ? pi : pi + 16; }
        return true;
    }
    __device__ __forceinline__ void a_ready(const pg8::Unit&) const {}
    __device__ __forceinline__ void done(const pg8::Unit&) const {}
};
struct Order2 {
    int G, c;
    __device__ __forceinline__ bool next(int i, pg8::Unit& u) const {
        const long L = (long)i * G + c; if (L >= 256) return false;
        int wgid = (int)L; { const int xcd = wgid % 8, off = wgid / 8; wgid = xcd * 32 + off; }
        const int g = wgid / 64, rem = wgid % 64; u.pm = g * 8 + (rem & 7); u.pn = rem >> 3;
        return true;
    }
    __device__ __forceinline__ void a_ready(const pg8::Unit&) const {}
    __device__ __forceinline__ void done(const pg8::Unit&) const {}
};

struct Epi1 {
    static constexpr bool PERM = true, AFTER_DRAIN = false;
    bf16 *XA, *GA, *Q, *FF, *FB, *V, *GB;
    __device__ __forceinline__ void operator()(const pg8::f32x4 (&acc)[2][2][4][2], const pg8::Unit& u, int wr, int wc, int fr, int fq) const {
        const int grp = u.pn >> 3;
        const int cg0 = (u.pn & 7) * 256 + wc * 32 + 8 * fq;
        const bool is_ctx = u.pm >= 32;
        bf16* base; int mode;
        switch (grp) {
            case 0: base = XA; mode = 0; break;
            case 1: base = GA; mode = 1; break;
            case 2: base = Q; mode = 2; break;
            case 3: base = FF; mode = 3; break;
            case 4: base = FB; mode = 3; break;
            case 5: base = V; mode = 3; break;
            default: base = GB; mode = 1; break;
        }
        const bool act = (mode == 1 || mode == 2);
#pragma unroll
        for (int ai = 0; ai < 2; ++ai)
#pragma unroll
            for (int m = 0; m < 4; ++m) {
                const int rl = 128 * ai + 64 * wr + 16 * m + fr;
                size_t drow;
                if (is_ctx) { const int R = (u.pm - 32) * 256 + rl; drow = (size_t)(R >> 8) * TT + (R & 255); }
                else { const int R = u.pm * 256 + rl; const int b = R >> 12, t = R & 4095, j = ((t & 63) << 6) | (t >> 6);
                    drow = (mode == 0) ? (size_t)b * TT + CTXL + t : (mode == 1) ? (size_t)R : (mode == 2) ? (size_t)b * SEQ + j : (size_t)b * TT + CTXL + j; }
                bf16* rowp = base + drow * DM + cg0;
#pragma unroll
                for (int bj = 0; bj < 2; ++bj) { pg8::f32x4 v0 = acc[ai][bj][m][0], v1 = acc[ai][bj][m][1];
                    if (act) {
#pragma unroll
                        for (int e = 0; e < 4; ++e) { v0[e] = siluf_(v0[e]); v1[e] = siluf_(v1[e]); } }
                    pg8::u32x4 w; w.x = pg8::cvt_pk_bf16(v0[0], v0[1]); w.y = pg8::cvt_pk_bf16(v0[2], v0[3]); w.z = pg8::cvt_pk_bf16(v1[0], v1[1]); w.w = pg8::cvt_pk_bf16(v1[2], v1[3]);
                    *(pg8::u32x4*)(rowp + bj * 128) = w; }
            }
    }
};
struct Epi2 {
    static constexpr bool PERM = false, AFTER_DRAIN = false;
    const float* x; const float* mod; float* out;
    __device__ __forceinline__ void operator()(const pg8::f32x4 (&acc)[2][2][4][2], const pg8::Unit& u, int wr, int wc, int fr, int fq) const {
        const int row0 = u.pm * 256 + wr * 64 + fr, col0 = u.pn * 256 + wc * 32 + 4 * fq;
        const int b = (u.pm * 256) >> 12;
        const float* gate = mod + (size_t)b * 6144 + 4096;
        pg8::f32x4 gv[2][2];
#pragma unroll
        for (int bj = 0; bj < 2; ++bj)
#pragma unroll
            for (int n = 0; n < 2; ++n) gv[bj][n] = *(const pg8::f32x4*)(gate + col0 + bj * 128 + n * 16);
#pragma unroll
        for (int ai = 0; ai < 2; ++ai)
#pragma unroll
            for (int m = 0; m < 4; ++m) { const size_t off = (size_t)(row0 + ai * 128 + m * 16) * DM + col0;
#pragma unroll
                for (int bj = 0; bj < 2; ++bj)
#pragma unroll
                    for (int n = 0; n < 2; ++n) { const pg8::f32x4 xv = *(const pg8::f32x4*)(x + off + bj * 128 + n * 16);
                        *(pg8::f32x4*)(out + off + bj * 128 + n * 16) = xv + gv[bj][n] * acc[ai][bj][m][n]; } }
    }
};

__device__ __forceinline__ int seq_pos(int dir, int s) { return dir == 0 ? s : (s < CTXL ? CTXL - 1 - s : TT - 1 - (s - CTXL)); }

__device__ __forceinline__ void rglru_naive_item(const Args& a, int b, int n, LAS float* sm) {
    LAS float* U = sm; LAS float* ZR = sm + 2048; LAS float* ZI = sm + 4096;
    const int tid = threadIdx.x;
    const bf16* XA = (const bf16*)(a.ws + WS_XA); const bf16* GA = (const bf16*)(a.ws + WS_GA);
    bf16* TMP = (bf16*)(a.ws + WS_TMPA); bf16* Y = (bf16*)(a.ws + WS_Y);
    const int c = tid & 127, ch = n * 128 + c;
    const float cw0 = a.in[I_CONVW][0 * DM + ch], cw1 = a.in[I_CONVW][1 * DM + ch], cw2 = a.in[I_CONVW][2 * DM + ch], cw3 = a.in[I_CONVW][3 * DM + ch], cb = a.in[I_CONVB][ch];
    for (int dir = 0; dir < 2; ++dir) {
        float h = 0.f;
        const float* Wr = a.in[I_WR] + (size_t)(dir * 16 + n) * 128 * 128;
        const float* Wi = a.in[I_WI] + (size_t)(dir * 16 + n) * 128 * 128;
        const float lam = a.in[I_LAM][dir * DM + ch];
        const float sp = (-lam > 20.f) ? -lam : log1pf(__expf(-lam));
        const int gate = tid >> 8, d = tid & 127, half = (tid >> 7) & 1;
        const float gbias = (gate ? a.in[I_BI] : a.in[I_BR])[dir * DM + n * 128 + d];
        const float* W = gate ? Wi : Wr;
        for (int tile = 0; tile < TT / 16; ++tile) {
#pragma unroll
            for (int j = 0; j < 4; ++j) {
                const int i = (tid >> 7) + 4 * j, s = tile * 16 + i, pos = seq_pos(dir, s);
                const int lo = (s < CTXL) ? 0 : CTXL, hi = (s < CTXL) ? CTXL : TT;
                const bf16* xp = XA + ((size_t)b * TT) * DM + ch;
                float acc = cb;
                if (pos - 2 >= lo) acc += bf2f(xp[(size_t)(pos - 2) * DM]) * cw0;
                if (pos - 1 >= lo) acc += bf2f(xp[(size_t)(pos - 1) * DM]) * cw1;
                acc += bf2f(xp[(size_t)pos * DM]) * cw2;
                if (pos + 1 < hi) acc += bf2f(xp[(size_t)(pos + 1) * DM]) * cw3;
                U[i * 128 + c] = acc;
            }
            __syncthreads();
            {
                float z[8];
#pragma unroll
                for (int i8 = 0; i8 < 8; ++i8) z[i8] = gbias;
                for (int cc = 0; cc < 128; ++cc) { const float w = W[cc * 128 + d];
#pragma unroll
                    for (int i8 = 0; i8 < 8; ++i8) z[i8] += U[(half * 8 + i8) * 128 + cc] * w; }
                LAS float* Z = gate ? ZI : ZR;
#pragma unroll
                for (int i8 = 0; i8 < 8; ++i8) Z[(half * 8 + i8) * 128 + d] = sigmoidf_(z[i8]);
            }
            __syncthreads();
            if (tid < 128) {
                for (int i = 0; i < 16; ++i) {
                    const float r = ZR[i * 128 + c], ig = ZI[i * 128 + c], u = U[i * 128 + c];
                    const float log_a = -8.0f * r * sp;
                    const float av = __expf(log_a);
                    const float bx = sqrtf(fmaxf(-expm1f(2.0f * log_a), 0.f)) * (ig * u);
                    h = av * h + bx;
                    const int s = tile * 16 + i;
                    if (s >= CTXL) { const int t = seq_pos(dir, s) - CTXL; const size_t idx = ((size_t)b * SEQ + t) * DM + ch;
                        if (dir == 0) TMP[idx] = (bf16)f2bf(h);
                        else { const float y = (bf2f(TMP[idx]) + h) * bf2f(GA[idx]); Y[((size_t)b * SEQ + t) * DMIX + ch] = (bf16)f2bf(y); } }
                }
            }
            __syncthreads();
        }
    }
}

__device__ __forceinline__ void hgrn_naive_item(const Args& a, int b, int hd, LAS float* sm) {
    LAS float* Fm = sm; LAS float* Qm = sm + 2048; LAS float* Vm = sm + 4096; LAS float* RED = sm + 6144;
    const int tid = threadIdx.x, lane = tid & 63, wave = tid >> 6;
    const bf16* Qg = (const bf16*)(a.ws + WS_Q); const bf16* Vg = (const bf16*)(a.ws + WS_V); const bf16* GB = (const bf16*)(a.ws + WS_GB);
    bf16* TMP = (bf16*)(a.ws + WS_TMPB); bf16* Y = (bf16*)(a.ws + WS_Y);
    const int v = tid & 127, kq = tid >> 7;
    for (int dir = 0; dir < 2; ++dir) {
        const bf16* Fg = (const bf16*)(a.ws + (dir ? WS_FB : WS_FF));
        float S[32];
#pragma unroll
        for (int kk = 0; kk < 32; ++kk) S[kk] = 0.f;
        const int kch = hd * 128 + (tid & 127);
        const float l0 = a.in[I_LB][(dir * 2 + 0) * DM + kch], l1 = a.in[I_LB][(dir * 2 + 1) * DM + kch];
        const float lb = sigmoidf_(l0 - l1);
        for (int tile = 0; tile < TT / 16; ++tile) {
#pragma unroll
            for (int j = 0; j < 4; ++j) {
                const int i = (tid >> 7) + 4 * j, s = tile * 16 + i, pos = seq_pos(dir, s);
                const size_t ridx = ((size_t)b * TT + pos) * DM + kch;
                const float fpre = bf2f(Fg[ridx]);
                Fm[i * 128 + (tid & 127)] = lb + (1.0f - lb) * sigmoidf_(fpre);
                Vm[i * 128 + (tid & 127)] = bf2f(Vg[ridx]);
                Qm[i * 128 + (tid & 127)] = (s >= CTXL) ? bf2f(Qg[((size_t)b * SEQ + pos - CTXL) * DM + kch]) : 0.f;
            }
            __syncthreads();
            for (int i = 0; i < 16; ++i) {
                const float vv = Vm[i * 128 + v]; float part = 0.f;
#pragma unroll
                for (int kk = 0; kk < 32; ++kk) { const int k = kq * 32 + kk; const float f = Fm[i * 128 + k];
                    S[kk] = f * S[kk] + (1.0f - f) * vv; part += Qm[i * 128 + k] * S[kk]; }
                RED[(i * 4 + kq) * 128 + v] = part;
            }
            __syncthreads();
            if (tile >= CTXL / 16) {
#pragma unroll
                for (int ii = 0; ii < 2; ++ii) {
                    const int i = wave * 2 + ii, s = tile * 16 + i, j = seq_pos(dir, s) - CTXL;
                    float o[2];
#pragma unroll
                    for (int e = 0; e < 2; ++e) { const int vv = lane + 64 * e; o[e] = RED[(i * 4 + 0) * 128 + vv] + RED[(i * 4 + 1) * 128 + vv] + RED[(i * 4 + 2) * 128 + vv] + RED[(i * 4 + 3) * 128 + vv]; }
                    const size_t idx = ((size_t)b * SEQ + j) * DM + hd * 128 + lane;
                    if (dir == 0) { TMP[idx] = (bf16)f2bf(o[0]); TMP[idx + 64] = (bf16)f2bf(o[1]); }
                    else {
                        o[0] += bf2f(TMP[idx]); o[1] += bf2f(TMP[idx + 64]);
                        const float ss = wave_sum(o[0] * o[0] + o[1] * o[1]);
                        const float rs = 1.0f / sqrtf(ss * (1.0f / 128.0f) + EPS);
                        const int t = ((j & 63) << 6) | (j >> 6);
                        const size_t gidx = ((size_t)b * SEQ + t) * DM + hd * 128 + lane;
#pragma unroll
                        for (int e = 0; e < 2; ++e) { const float y = o[e] * rs * a.in[I_HNW][lane + 64 * e] * bf2f(GB[gidx + 64 * e]);
                            Y[((size_t)b * SEQ + t) * DMIX + DM + hd * 128 + lane + 64 * e] = (bf16)f2bf(y); }
                    }
                }
            }
            __syncthreads();
        }
    }
}

__global__ void __launch_bounds__(NTHR, 2) fwd_kernel(Args args) {
    extern __shared__ __attribute__((aligned(16))) unsigned char lds_raw[];
    LAS unsigned char* lds = (LAS unsigned char*)lds_raw;
    volatile LAS unsigned* MISC = (volatile LAS unsigned*)(lds + MISC_OFF);
    const int tid = threadIdx.x, lane = tid & 63, wave = __builtin_amdgcn_readfirstlane(tid >> 6);
    const int G = gridDim.x, bx = blockIdx.x;
    unsigned char* ws = args.ws;
    unsigned* ctl = (unsigned*)(ws + WS_CTL);
    for (int u = tid; u < (LDS_BYTES - LDSCTL_OFF) / 4; u += NTHR) ((LAS unsigned*)(lds + LDSCTL_OFF))[u] = 0u;
    __syncthreads();
    const int lo = args.ph_lo, hi = args.ph_hi;
    const bool fused = (hi - lo) > 1;
    XcdBarrier bar; bar.bar = ctl + CW_BAR; bar.x = 0; bar.st = nullptr;
    if (fused) bar = xcd_barrier_post(ctl + CW_BAR, MISC + 8);
#define IN(k) (lo <= (k) && (k) < hi)
#define BOTH(k) (IN(k) && IN((k) + 1))
#define GRID_BAR() xcd_barrier(bar)

    float* MOD = (float*)(ws + WS_MOD);
    bf16* WIN_T = (bf16*)(ws + WS_WIN); bf16* WOUT_T = (bf16*)(ws + WS_WOUT); bf16* H = (bf16*)(ws + WS_H);

    if (IN(0)) {
        LAS float* SC = (LAS float*)lds;
        LAS float* RED = (LAS float*)(lds + 24576);
        bool sc_ready = false;
        for (int item = bx; item < 192; item += G) {
            if (!sc_ready) {
                for (int i = tid; i < 3 * DM; i += NTHR) { const int v = i / DM, k = i % DM; const float cv = (v < 2) ? args.in[I_C][v * DM + k] : args.in[I_CCTX][k]; SC[i] = siluf_(cv); }
                sc_ready = true;
            }
            __syncthreads();
            float acc[3][4];
#pragma unroll
            for (int v = 0; v < 3; ++v)
#pragma unroll
                for (int e = 0; e < 4; ++e) acc[v][e] = 0.f;
            const float* Wp = args.in[I_ADAW] + (size_t)(wave * 256 + (lane >> 3)) * 6144 + item * 32 + 4 * (lane & 7);
#pragma unroll 8
            for (int it = 0; it < 32; ++it) {
                const f32x4 wv = *(const f32x4*)(Wp + (size_t)it * 8 * 6144);
                const int k = wave * 256 + it * 8 + (lane >> 3);
#pragma unroll
                for (int v = 0; v < 3; ++v) { const float s = SC[v * DM + k];
#pragma unroll
                    for (int e = 0; e < 4; ++e) acc[v][e] += s * wv[e]; }
            }
#pragma unroll
            for (int v = 0; v < 3; ++v)
#pragma unroll
                for (int e = 0; e < 4; ++e) { float x = acc[v][e]; x += __shfl_xor(x, 8); x += __shfl_xor(x, 16); x += __shfl_xor(x, 32); acc[v][e] = x; }
            if (lane < 8) {
#pragma unroll
                for (int v = 0; v < 3; ++v)
#pragma unroll
                    for (int e = 0; e < 4; ++e) RED[(wave * 3 + v) * 32 + 4 * lane + e] = acc[v][e];
            }
            __syncthreads();
            if (tid < 96) { const int v = tid >> 5, col = tid & 31; float s = args.in[I_ADAB][item * 32 + col];
#pragma unroll
                for (int w = 0; w < 8; ++w) s += RED[(w * 3 + v) * 32 + col];
                MOD[v * 6144 + item * 32 + col] = s; }
            __syncthreads();
        }
        __syncthreads();
        LAS float* scr = (LAS float*)(lds + wave * 16384);
        const int gw = bx * NWAVES + wave, NGW = G * NWAVES;
        constexpr int I_1 = (DM / 64) * (INC / 32), I_2 = (DMIX / 64) * (DM / 32);
        for (int it = gw; it < I_1 + I_2; it += NGW) {
            if (it < I_1) p0_transpose_item(args.in[I_WIN], DM, INC, WIN_T, scr, it, lane);
            else p0_transpose_item(args.in[I_WOUT], DMIX, DM, WOUT_T, scr, it - I_1, lane);
        }
        if (BOTH(0)) GRID_BAR();
    }

    if (IN(1)) {
        const int gw = bx * NWAVES + wave, NGW = G * NWAVES;
        for (int R = gw; R < MTOT; R += NGW) {
            const float* src; int mv;
            if (R < MLAT) { src = args.in[I_X] + (size_t)R * DM; mv = R >> 12; } else { src = args.in[I_CTX] + (size_t)(R - MLAT) * DM; mv = 2; }
            const float* shift = MOD + mv * 6144; const float* scale = shift + DM;
            f32x4 v[8]; float ss = 0.f;
#pragma unroll
            for (int j = 0; j < 8; ++j) { v[j] = *(const f32x4*)(src + 4 * lane + 256 * j); ss += (v[j].x * v[j].x + v[j].y * v[j].y) + (v[j].z * v[j].z + v[j].w * v[j].w); }
            const float rs = 1.0f / sqrtf(wave_sum(ss) * (1.0f / DM) + EPS);
            bf16* dst = H + (size_t)R * DM;
#pragma unroll
            for (int j = 0; j < 8; ++j) { const int c0 = 4 * lane + 256 * j;
                const f32x4 nw = *(const f32x4*)(args.in[I_NORMW] + c0), sc = *(const f32x4*)(scale + c0), sh = *(const f32x4*)(shift + c0);
                const f32x4 o = (v[j] * rs) * nw * (1.0f + sc) + sh;
                v2u w; w.x = pk2(o.x, o.y); w.y = pk2(o.z, o.w); *(v2u*)(dst + c0) = w; }
        }
        if (BOTH(1)) GRID_BAR();
    }

    if (IN(2)) {
        pg8::Gemm g{H, WIN_T, MTOT, INC, DM}; Order1 S{G, bx};
        Epi1 E{(bf16*)(ws + WS_XA), (bf16*)(ws + WS_GA), (bf16*)(ws + WS_Q), (bf16*)(ws + WS_FF), (bf16*)(ws + WS_FB), (bf16*)(ws + WS_V), (bf16*)(ws + WS_GB)};
        pg8::gemm_phase<Epi1, Order1, true, true>(lds, g, S, E);
        if (BOTH(2)) GRID_BAR();
    }

    if (IN(3)) {
        for (int item = bx; item < 64; item += G) {
            if (item < 32) rglru_naive_item(args, item >> 4, item & 15, (LAS float*)lds);
            else hgrn_naive_item(args, (item - 32) >> 4, (item - 32) & 15, (LAS float*)lds);
            __syncthreads();
        }
        if (BOTH(3)) GRID_BAR();
    }

    if (IN(4)) {
        pg8::Gemm g{(const bf16*)(ws + WS_Y), WOUT_T, MLAT, DM, DMIX}; Order2 S{G, bx};
        Epi2 E{args.in[I_X], MOD, args.out};
        pg8::gemm_phase<Epi2, Order2, false, true>(lds, g, S, E);
        if (BOTH(4)) GRID_BAR();
    }

    if (IN(5)) {
        const int gw = bx * NWAVES + wave, NGW = G * NWAVES;
        for (int R = gw; R < MLAT; R += NGW) {
            float* row = args.out + (size_t)R * DM;
            f32x4 v[8]; float ss = 0.f;
#pragma unroll
            for (int j = 0; j < 8; ++j) { v[j] = *(const f32x4*)(row + 4 * lane + 256 * j); ss += (v[j].x * v[j].x + v[j].y * v[j].y) + (v[j].z * v[j].z + v[j].w * v[j].w); }
            const float rs = 1.0f / sqrtf(wave_sum(ss) * (1.0f / DM) + EPS);
#pragma unroll
            for (int j = 0; j < 8; ++j) { const int c0 = 4 * lane + 256 * j; const f32x4 nw = *(const f32x4*)(args.in[I_FNW] + c0);
                *(f32x4*)(row + c0) = (v[j] * rs) * nw; }
        }
    }
#undef IN
#undef BOTH
#undef GRID_BAR
}

extern "C" void kernel_launch(void* const* d_in, const int* in_sizes, int n_in, void* d_out, int out_size, void* d_ws, size_t ws_size, hipStream_t stream) {
    static int grid = 0;
    if (grid == 0) {
        if (n_in != 19 || out_size != MLAT * DM || ws_size < WS_END) { fprintf(stderr, "kernel_launch: unexpected problem shape (n_in %d out %d ws %zu)\n", n_in, out_size, ws_size); grid = -1; return; }
        int dev = 0, cus = 0, per_cu = 0;
        if (hipGetDevice(&dev) != hipSuccess || hipDeviceGetAttribute(&cus, hipDeviceAttributeMultiprocessorCount, dev) != hipSuccess) { grid = -1; return; }
        if (hipFuncSetAttribute((const void*)fwd_kernel, hipFuncAttributeMaxDynamicSharedMemorySize, LDS_BYTES) != hipSuccess) { fprintf(stderr, "kernel_launch: hipFuncSetAttribute failed\n"); grid = -1; return; }
        if (hipOccupancyMaxActiveBlocksPerMultiprocessor(&per_cu, (const void*)fwd_kernel, NTHR, LDS_BYTES) != hipSuccess || per_cu < 1) { fprintf(stderr, "kernel_launch: occupancy query failed (%d)\n", per_cu); grid = -1; (void)hipGetLastError(); return; }
        grid = cus * 1;
    }
    if (grid < 0) return;
    (void)hipMemsetAsync((char*)d_ws + WS_CTL, 0, CTL_ZERO_BYTES, stream);
    Args a{};
    for (int i = 0; i < 19; ++i) a.in[i] = (const float*)d_in[i];
    a.out = (float*)d_out; a.ws = (unsigned char*)d_ws;
#if MK_N_LAUNCHES == 1
    a.ph_lo = 0; a.ph_hi = NPHASE;
    void* kargs[] = {&a};
    hipError_t e = hipLaunchCooperativeKernel((const void*)fwd_kernel, dim3(grid), dim3(NTHR), kargs, LDS_BYTES, stream);
    if (e != hipSuccess) fprintf(stderr, "cooperative launch failed: %s (grid %d)\n", hipGetErrorString(e), grid);
#else
    for (int p = 0; p < NPHASE; ++p) {
        a.ph_lo = p; a.ph_hi = p + 1;
        hipLaunchKernelGGL(fwd_kernel, dim3(grid), dim3(NTHR), LDS_BYTES, stream, a);
    }
#endif
}
```

```cpp
#include <hip/hip_runtime.h>
#include <hip/hip_cooperative_groups.h>
#include <cstdio>
#include <cstdint>

#ifndef MK_N_LAUNCHES
#define MK_N_LAUNCHES 1
#endif

namespace pg8 {
#define PG8_LAS __attribute__((address_space(3)))
typedef unsigned short bf16_t;
typedef short bf16x8 __attribute__((ext_vector_type(8)));
typedef float f32x4 __attribute__((ext_vector_type(4)));
typedef unsigned u32x4 __attribute__((ext_vector_type(4)));
constexpr int BM = 256, BK = 64, HALF = 128, HTB = HALF * BK * 2, STAGE_BYTES = 8 * HTB, NXCD = 8, WGM = 8;

__host__ __device__ __forceinline__ int lds_byte(int r, int c) { const int st = (r >> 4) * 2 + (c >> 5), rr = r & 15, cc = c & 31, ob = rr * 64 + cc * 2; return st * 1024 + (ob ^ (((ob >> 9) & 1) << 5)); }
__host__ __device__ __forceinline__ void stage_rc(int b, int& R, int& C) { const int st = b / 1024, sb = b % 1024, swz = sb ^ (((sb >> 9) & 1) << 5); R = (st >> 1) * 16 + swz / 64; C = (st & 1) * 32 + (swz % 64) / 2; }
__host__ __device__ __forceinline__ int perm32(int rho) { const int n = rho >> 4, i = rho & 15; return 8 * (i >> 2) + 4 * n + (i & 3); }

struct Unit { int pm, pn; };
struct Gemm { const bf16_t* A; const bf16_t* Bt; int M, N, K; };

__device__ __forceinline__ unsigned cvt_pk_bf16(float lo, float hi) { unsigned r; asm volatile("v_cvt_pk_bf16_f32 %0, %1, %2" : "=v"(r) : "v"(lo), "v"(hi)); return r; }

template <class Epi, class Sched, bool ALIGN_EPI = false, bool SP2 = false>
__device__ __forceinline__ void gemm_phase(PG8_LAS unsigned char* lds, const Gemm g, const Sched& S, const Epi& E) {
    const int tid = threadIdx.x, wid = __builtin_amdgcn_readfirstlane(tid >> 6), lane = tid & 63, wr = wid >> 2, wc = wid & 3, fr = lane & 15, fq = lane >> 4;
    const int K = g.K, nt = K / BK;
    unsigned voffA[2], voffB[2];
#pragma unroll
    for (int i = 0; i < 2; ++i) { int R, C; stage_rc(tid * 16 + i * 8192, R, C); const int Rb = Epi::PERM ? ((R & ~31) + perm32(R & 31)) : R;
        voffA[i] = (unsigned)(R * K + C) * 2u; voffB[i] = (unsigned)(Rb * K + C) * 2u; }
    const size_t kstep = (size_t)(BK * 2);
    const size_t hstep = (size_t)HALF * K * 2;
    const size_t tstep = 2 * hstep;
    const unsigned ldsw = (unsigned)wid * 1024u;
    const int aoff = lds_byte(wr * 64 + fr, fq * 8), boff = lds_byte(wc * 32 + fr, fq * 8);
#define PG8_SA(b, h) (((b) * 2 + (h)) * HTB)
#define PG8_SB(b, h) ((4 + (b) * 2 + (h)) * HTB)
#define PG8_STAGE(bufoff, gbase, voff) do { _Pragma("unroll") for (int _i = 0; _i < 2; ++_i) \
        __builtin_amdgcn_global_load_lds((const unsigned*)((const char*)(gbase) + (voff)[_i]), (PG8_LAS unsigned*)(lds + (bufoff) + ldsw + _i * 8192), 16, 0, 0); } while (0)
#define PG8_LDA(dst, b, h) do { _Pragma("unroll") for (int m = 0; m < 4; ++m) _Pragma("unroll") for (int k = 0; k < 2; ++k) dst[m][k] = *(const PG8_LAS bf16x8*)(lds + PG8_SA(b, h) + aoff + m * 2048 + k * 1024); } while (0)
#define PG8_LDB(dst, b, h) do { _Pragma("unroll") for (int n = 0; n < 2; ++n) _Pragma("unroll") for (int k = 0; k < 2; ++k) dst[n][k] = *(const PG8_LAS bf16x8*)(lds + PG8_SB(b, h) + boff + n * 2048 + k * 1024); } while (0)
#define PG8_MMA(ai, bj, At, Bt) do { __builtin_amdgcn_s_setprio(1); _Pragma("unroll") for (int m = 0; m < 4; ++m) _Pragma("unroll") for (int n = 0; n < 2; ++n) _Pragma("unroll") for (int k = 0; k < 2; ++k) \
        acc[ai][bj][m][n] = __builtin_amdgcn_mfma_f32_16x16x32_bf16(Bt[n][k], At[m][k], acc[ai][bj][m][n], 0, 0, 0); __builtin_amdgcn_s_setprio(0); } while (0)
#define PG8_WAIT_V(n) asm volatile("s_waitcnt vmcnt(" #n ")" ::: "memory")
#define PG8_WAIT_L(n) asm volatile("s_waitcnt lgkmcnt(" #n ")" ::: "memory")
#define PG8_BAR __builtin_amdgcn_s_barrier()
#define PG8_SCHED __builtin_amdgcn_sched_barrier(0)
    Unit cur, nxt; int ui = 0;
    if (!S.next(0, cur)) return;
    f32x4 acc[2][2][4][2];
#pragma unroll
    for (int a = 0; a < 2; ++a)
#pragma unroll
        for (int b = 0; b < 2; ++b)
#pragma unroll
            for (int m = 0; m < 4; ++m)
#pragma unroll
                for (int n = 0; n < 2; ++n) acc[a][b][m][n] = (f32x4){0.f, 0.f, 0.f, 0.f};
    bf16x8 At[4][2], B0[2][2], B1[2][2];
    const char* cA = (const char*)g.A + (size_t)cur.pm * tstep; const char* cB = (const char*)g.Bt + (size_t)cur.pn * tstep;
    S.a_ready(cur);
    if constexpr (SP2) {
        PG8_STAGE(PG8_SB(0, 0), cB, voffB); PG8_STAGE(PG8_SB(0, 1), cB + hstep, voffB); PG8_STAGE(PG8_SA(0, 0), cA, voffA); PG8_STAGE(PG8_SA(0, 1), cA + hstep, voffA);
        if (wr == 1) PG8_BAR;
        PG8_WAIT_V(2); PG8_BAR;
        PG8_STAGE(PG8_SB(1, 0), cB + kstep, voffB); PG8_STAGE(PG8_SA(1, 0), cA + kstep, voffA); PG8_STAGE(PG8_SB(1, 1), cB + hstep + kstep, voffB);
        PG8_WAIT_V(6); PG8_BAR;
    } else {
        PG8_STAGE(PG8_SB(0, 0), cB, voffB); PG8_STAGE(PG8_SA(0, 0), cA, voffA); PG8_STAGE(PG8_SB(0, 1), cB + hstep, voffB); PG8_STAGE(PG8_SA(0, 1), cA + hstep, voffA);
        if (wr == 1) PG8_BAR;
        PG8_WAIT_V(4); PG8_BAR;
        PG8_STAGE(PG8_SB(1, 0), cB + kstep, voffB); PG8_STAGE(PG8_SA(1, 0), cA + kstep, voffA); PG8_STAGE(PG8_SB(1, 1), cB + hstep + kstep, voffB);
        PG8_WAIT_V(6); PG8_BAR;
    }
    for (;;) {
        const bool has_next = S.next(ui + 1, nxt);
        const char* nA = has_next ? (const char*)g.A + (size_t)nxt.pm * tstep : cA; const char* nB = has_next ? (const char*)g.Bt + (size_t)nxt.pn * tstep : cB;
        for (int t = 0; t < nt; t += 2) {
            const bool last = (t == nt - 2);
            const char* a1 = cA + (size_t)(t + 1) * kstep;
            const char* a2 = last ? nA : cA + (size_t)(t + 2) * kstep; const char* b2 = last ? nB : cB + (size_t)(t + 2) * kstep;
            const char* a3 = a2 + kstep; const char* b3 = b2 + kstep;
            if (last && has_next) S.a_ready(nxt);
            if constexpr (SP2) {
            PG8_LDB(B0, 0, 0); PG8_LDB(B1, 0, 1); PG8_SCHED; PG8_LDA(At, 0, 0); PG8_STAGE(PG8_SA(1, 1), a1 + hstep, voffA);
            PG8_WAIT_V(8); PG8_WAIT_L(0); PG8_BAR; PG8_MMA(0, 0, At, B0); PG8_MMA(0, 1, At, B1); PG8_BAR; PG8_SCHED;
            PG8_LDA(At, 0, 1); PG8_STAGE(PG8_SB(0, 0), b2, voffB); PG8_STAGE(PG8_SB(0, 1), b2 + hstep, voffB); PG8_STAGE(PG8_SA(0, 0), a2, voffA);
            PG8_WAIT_V(8); PG8_WAIT_L(0); PG8_BAR; PG8_MMA(1, 0, At, B0); PG8_MMA(1, 1, At, B1); PG8_BAR; PG8_SCHED;
            PG8_LDB(B0, 1, 0); PG8_LDB(B1, 1, 1); PG8_SCHED; PG8_LDA(At, 1, 0); PG8_STAGE(PG8_SA(0, 1), a2 + hstep, voffA);
            PG8_WAIT_V(8); PG8_WAIT_L(0); PG8_BAR; PG8_MMA(0, 0, At, B0); PG8_MMA(0, 1, At, B1); PG8_BAR; PG8_SCHED;
            PG8_LDA(At, 1, 1); PG8_STAGE(PG8_SB(1, 0), b3, voffB); PG8_STAGE(PG8_SB(1, 1), b3 + hstep, voffB); PG8_STAGE(PG8_SA(1, 0), a3, voffA);
            PG8_WAIT_V(8); PG8_WAIT_L(0); PG8_BAR; PG8_MMA(1, 0, At, B0); PG8_MMA(1, 1, At, B1); PG8_BAR; PG8_SCHED;
            } else {
            PG8_LDB(B0, 0, 0); PG8_SCHED; PG8_LDA(At, 0, 0); PG8_STAGE(PG8_SA(1, 1), a1 + hstep, voffA);
            PG8_WAIT_L(8); PG8_BAR; PG8_WAIT_L(0); PG8_MMA(0, 0, At, B0); PG8_BAR; PG8_SCHED;
            PG8_LDB(B1, 0, 1); PG8_STAGE(PG8_SB(0, 0), b2, voffB);
            PG8_BAR; PG8_WAIT_L(0); PG8_MMA(0, 1, At, B1); PG8_BAR;
            PG8_LDA(At, 0, 1); PG8_STAGE(PG8_SA(0, 0), a2, voffA);
            PG8_BAR; PG8_WAIT_L(0); PG8_MMA(1, 0, At, B0); PG8_BAR; PG8_SCHED;
            PG8_STAGE(PG8_SB(0, 1), b2 + hstep, voffB);
            PG8_WAIT_V(6); PG8_BAR; PG8_MMA(1, 1, At, B1); PG8_BAR;
            PG8_LDB(B0, 1, 0); PG8_SCHED; PG8_LDA(At, 1, 0); PG8_STAGE(PG8_SA(0, 1), a2 + hstep, voffA);
            PG8_WAIT_L(8); PG8_BAR; PG8_WAIT_L(0); PG8_MMA(0, 0, At, B0); PG8_BAR; PG8_SCHED;
            PG8_LDB(B1, 1, 1); PG8_STAGE(PG8_SB(1, 0), b3, voffB);
            PG8_BAR; PG8_WAIT_L(0); PG8_MMA(0, 1, At, B1); PG8_BAR;
            PG8_LDA(At, 1, 1); PG8_STAGE(PG8_SA(1, 0), a3, voffA);
            PG8_BAR; PG8_WAIT_L(0); PG8_MMA(1, 0, At, B0); PG8_BAR; PG8_SCHED;
            PG8_STAGE(PG8_SB(1, 1), b3 + hstep, voffB);
            PG8_WAIT_V(6); PG8_BAR; PG8_MMA(1, 1, At, B1); PG8_BAR;
            }
        }
        if constexpr (ALIGN_EPI) { if (wr == 0) PG8_BAR; }
        E(acc, cur, wr, wc, fr, fq); S.done(cur);
        if (!has_next) break;
#pragma unroll
        for (int a = 0; a < 2; ++a)
#pragma unroll
            for (int b = 0; b < 2; ++b)
#pragma unroll
                for (int m = 0; m < 4; ++m)
#pragma unroll
                    for (int n = 0; n < 2; ++n) acc[a][b][m][n] = (f32x4){0.f, 0.f, 0.f, 0.f};
        cur = nxt; cA = nA; cB = nB; ++ui;
        if constexpr (ALIGN_EPI) { if (wr == 1) PG8_BAR; }
    }
    PG8_WAIT_V(0);
    if constexpr (!ALIGN_EPI) { if (wr == 0) PG8_BAR; }
    PG8_BAR;
#undef PG8_SA
#undef PG8_SB
#undef PG8_STAGE
#undef PG8_LDA
#undef PG8_LDB
#undef PG8_MMA
#undef PG8_WAIT_V
#undef PG8_WAIT_L
#undef PG8_BAR
#undef PG8_SCHED
}
}

constexpr int NWAVES = 8, NTHR = 512;
constexpr int DM = 2048, SEQ = 4096, CTXL = 256, NBATCH = 2, TT = CTXL + SEQ;
constexpr int MLAT = NBATCH * SEQ, MCTX = NBATCH * CTXL, MTOT = MLAT + MCTX;
constexpr int INC = 7 * DM;
constexpr int DMIX = 2 * DM;
constexpr float EPS = 1e-6f;
constexpr int NPHASE = 6;

constexpr size_t MiB = 1u << 20;
constexpr size_t WS_CTL = 0, CTL_ZERO_BYTES = 1 * MiB;
constexpr size_t WS_MOD = 1 * MiB;
constexpr size_t WS_WOUT = 4 * MiB;
constexpr size_t WS_WIN = 20 * MiB;
constexpr size_t WS_H = 76 * MiB;
constexpr size_t WS_XA = 110 * MiB;
constexpr size_t WS_FF = 144 * MiB;
constexpr size_t WS_FB = 178 * MiB;
constexpr size_t WS_V = 212 * MiB;
constexpr size_t WS_GA = 246 * MiB;
constexpr size_t WS_Q = 278 * MiB;
constexpr size_t WS_GB = 310 * MiB;
constexpr size_t WS_Y = 342 * MiB;
constexpr size_t WS_TMPA = 20 * MiB;
constexpr size_t WS_TMPB = 52 * MiB;
constexpr size_t WS_END = 406 * MiB;

constexpr int CW_BAR = 4096;

constexpr int RING_BYTES = 131072;
constexpr int LDSCTL_OFF = RING_BYTES, MISC_OFF = LDSCTL_OFF + 320;
constexpr int LDS_BYTES = 147456;

#define GAS __attribute__((address_space(1)))
#define LAS __attribute__((address_space(3)))
typedef unsigned short bf16;
typedef unsigned v4u __attribute__((ext_vector_type(4)));
typedef unsigned v2u __attribute__((ext_vector_type(2)));
typedef float f32x4 __attribute__((ext_vector_type(4)));
#define LDS_WAIT() asm volatile("s_waitcnt lgkmcnt(0)" ::: "memory")
#define VM_WAIT() asm volatile("s_waitcnt vmcnt(0)" ::: "memory")
__device__ __forceinline__ unsigned f2bf(float f) { unsigned u = __builtin_bit_cast(unsigned, f); return (u + 0x7fffu + ((u >> 16) & 1u)) >> 16; }
__device__ __forceinline__ unsigned pk2(float lo, float hi) { return f2bf(lo) | (f2bf(hi) << 16); }
__device__ __forceinline__ float bf2f(bf16 b) { return __builtin_bit_cast(float, ((unsigned)b) << 16); }
__device__ __forceinline__ float sigmoidf_(float x) { return 1.0f / (1.0f + __expf(-x)); }
__device__ __forceinline__ float siluf_(float x) { return x / (1.0f + __expf(-x)); }

#define XB_TMO      128
#define XB_XCNT(j)  (256  + 64 * (j))
#define XB_XSUB(j)  (1280 + 64 * (j))
#define XB_XGEN(j)  (2304 + 64 * (j))
#define XB_TOP      3328
#define XB_TOPGEN   3392
#define XCD_BAR_WORDS 3456
#define XB_SPIN_CAP (1u << 18)
__device__ __forceinline__ unsigned xb_ld(unsigned* p)              { return __hip_atomic_load(p, __ATOMIC_RELAXED, __HIP_MEMORY_SCOPE_AGENT); }
__device__ __forceinline__ unsigned xb_add(unsigned* p, unsigned v) { return __hip_atomic_fetch_add(p, v, __ATOMIC_RELAXED, __HIP_MEMORY_SCOPE_AGENT); }
__device__ __forceinline__ unsigned xb_xcc_id() { return (unsigned)__builtin_amdgcn_s_getreg((3 << 11) | 20) & 0xFu; }
#define XB_SPIN(cond, bar) do { unsigned _sp = 0; while (cond) { __builtin_amdgcn_s_sleep(1); \
    if ((++_sp & 255u) == 0u) { if (xb_ld(&(bar)[XB_TMO])) break; if (_sp > XB_SPIN_CAP) { atomicAdd(&(bar)[XB_TMO], 1u); break; } } } } while (0)
struct XcdBarrier { unsigned* bar; unsigned x; volatile LAS unsigned* st; };
__device__ __forceinline__ XcdBarrier xcd_barrier_post(unsigned* bar, volatile LAS unsigned* st) {
    XcdBarrier b; b.bar = bar; b.x = xb_xcc_id(); b.st = st;
    if (threadIdx.x == 0) (void)xb_add(&bar[XB_XCNT(b.x)], 1u);
    return b;
}
__device__ __forceinline__ void xcd_barrier_complete(unsigned* bar, unsigned x, unsigned& nloc, unsigned& nx) {
    const unsigned G = gridDim.x * gridDim.y * gridDim.z;
    unsigned sum, cnt, mine, sp = 0u;
    for (;;) {
        sum = 0u; cnt = 0u; mine = 0u;
#pragma unroll
        for (unsigned j = 0; j < 16; ++j) { const unsigned c = xb_ld(&bar[XB_XCNT(j)]); sum += c; cnt += (c > 0u) ? 1u : 0u; mine = (j == x) ? c : mine; }
        if (sum == G) break;
        __builtin_amdgcn_s_sleep(1);
        if ((++sp & 255u) == 0u) { if (xb_ld(&bar[XB_TMO])) break; if (sp > XB_SPIN_CAP) { atomicAdd(&bar[XB_TMO], 1u); break; } }
    }
    nloc = mine > 0u ? mine : 1u; nx = cnt > 0u ? cnt : 1u;
}
__device__ __forceinline__ void xcd_barrier(const XcdBarrier& b) {
    asm volatile("s_waitcnt vmcnt(0)" ::: "memory");
    __syncthreads();
    if (threadIdx.x == 0) {
        unsigned* bar = b.bar;
        __builtin_amdgcn_s_waitcnt(0);
        unsigned nloc = b.st[0], nx = b.st[1];
        if (nloc == 0u) { xcd_barrier_complete(bar, b.x, nloc, nx); b.st[0] = nloc; b.st[1] = nx; }
        const unsigned old = xb_add(&bar[XB_XSUB(b.x)], 1u);
        const unsigned gen = old / nloc;
        if (old + 1u == (gen + 1u) * nloc) {
            __builtin_amdgcn_fence(__ATOMIC_RELEASE, "agent");
            asm volatile("s_waitcnt vmcnt(0)" ::: "memory");
            const unsigned og = xb_add(&bar[XB_TOP], 1u);
            const unsigned tg = og / nx;
            if (og + 1u == (tg + 1u) * nx) xb_add(&bar[XB_TOPGEN], 1u);
            else XB_SPIN(xb_ld(&bar[XB_TOPGEN]) == tg, bar);
            __builtin_amdgcn_fence(__ATOMIC_ACQUIRE, "agent");
            xb_add(&bar[XB_XGEN(b.x)], 1u);
            asm volatile("s_waitcnt vmcnt(0)" ::: "memory");
        } else {
            XB_SPIN(xb_ld(&bar[XB_XGEN(b.x)]) == gen, bar);
            __builtin_amdgcn_fence(__ATOMIC_ACQUIRE, "agent");
            asm volatile("s_waitcnt vmcnt(0)" ::: "memory");
        }
    }
    __syncthreads();
}

struct Args {
    const float* in[19];
    float* out; unsigned char* ws;
    int ph_lo, ph_hi;
};
enum { I_X = 0, I_C, I_CTX, I_CCTX, I_ADAW, I_ADAB, I_NORMW, I_WIN, I_CONVW, I_CONVB, I_WR, I_BR, I_WI, I_BI, I_LAM, I_LB, I_HNW, I_WOUT, I_FNW };

__device__ __forceinline__ float wave_sum(float v) {
#pragma unroll
    for (int o = 1; o < 64; o <<= 1) v += __shfl_xor(v, o);
    return v;
}

__device__ __forceinline__ void p0_transpose_item(const float* W, int K, int N, bf16* WT, LAS float* scr, int item, int lane) {
    const int nblk = N / 32, kb = item / nblk, nb = item % nblk, k0 = 64 * kb, n0 = 32 * nb;
#pragma unroll 8
    for (int i = 0; i < 32; ++i) { const int kk = 2 * i + (lane >> 5); scr[kk * 33 + (lane & 31)] = W[(size_t)(k0 + kk) * N + n0 + (lane & 31)]; }
    LDS_WAIT(); asm volatile("" ::: "memory");
    const int c = lane & 7;
#pragma unroll
    for (int j = 0; j < 4; ++j) { const int n = (lane >> 3) + 8 * j; const LAS float* s = scr + (8 * c) * 33 + n;
        v4u o; o.x = pk2(s[0 * 33], s[1 * 33]); o.y = pk2(s[2 * 33], s[3 * 33]); o.z = pk2(s[4 * 33], s[5 * 33]); o.w = pk2(s[6 * 33], s[7 * 33]);
        *(GAS v4u*)(WT + (size_t)(n0 + n) * K + k0 + 8 * c) = o; }
    LDS_WAIT(); asm volatile("" ::: "memory");
}

struct Order1 {
    int G, c;
    __device__ __forceinline__ bool next(int i, pg8::Unit& u) const {
        const long L = (long)i * G + c; if (L >= 1856) return false;
        int wgid = (int)L; { const int xcd = wgid % 8, off = wgid / 8; wgid = xcd * 232 + off; }
        if (wgid < 1792) { const int g = wgid / 448, rem = wgid % 448; u.pm = g * 8 + (rem & 7); u.pn = rem >> 3; }
        else { const int w = wgid - 1792; u.pm = 32 + (w & 1); const int pi = w >> 1; u.pn = (pi < 8) ? pi : pi + 16; }
        return true;
    }
    __device__ __forceinline__ void a_ready(const pg8::Unit&) const {}
    __device__ __forceinline__ void done(const pg8::Unit&) const {}
};
struct Order2 {
    int G, c;
    __device__ __forceinline__ bool next(int i, pg8::Unit& u) const {
        const long L = (long)i * G + c; if (L >= 256) return false;
        int wgid = (int)L; { const int xcd = wgid % 8, off = wgid / 8; wgid = xcd * 32 + off; }
        const int g = wgid / 64, rem = wgid % 64; u.pm = g * 8 + (rem & 7); u.pn = rem >> 3;
        return true;
    }
    __device__ __forceinline__ void a_ready(const pg8::Unit&) const {}
    __device__ __forceinline__ void done(const pg8::Unit&) const {}
};

struct Epi1 {
    static constexpr bool PERM = true, AFTER_DRAIN = false;
    bf16 *XA, *GA, *Q, *FF, *FB, *V, *GB;
    __device__ __forceinline__ void operator()(const pg8::f32x4 (&acc)[2][2][4][2], const pg8::Unit& u, int wr, int wc, int fr, int fq) const {
        const int grp = u.pn >> 3;
        const int cg0 = (u.pn & 7) * 256 + wc * 32 + 8 * fq;
        const bool is_ctx = u.pm >= 32;
        bf16* base; int mode;
        switch (grp) {
            case 0: base = XA; mode = 0; break;
            case 1: base = GA; mode = 1; break;
            case 2: base = Q; mode = 2; break;
            case 3: base = FF; mode = 3; break;
            case 4: base = FB; mode = 3; break;
            case 5: base = V; mode = 3; break;
            default: base = GB; mode = 1; break;
        }
        const bool act = (mode == 1 || mode == 2);
#pragma unroll
        for (int ai = 0; ai < 2; ++ai)
#pragma unroll
            for (int m = 0; m < 4; ++m) {
                const int rl = 128 * ai + 64 * wr + 16 * m + fr;
                size_t drow;
                if (is_ctx) { const int R = (u.pm - 32) * 256 + rl; drow = (size_t)(R >> 8) * TT + (R & 255); }
                else { const int R = u.pm * 256 + rl; const int b = R >> 12, t = R & 4095, j = ((t & 63) << 6) | (t >> 6);
                    drow = (mode == 0) ? (size_t)b * TT + CTXL + t : (mode == 1) ? (size_t)R : (mode == 2) ? (size_t)b * SEQ + j : (size_t)b * TT + CTXL + j; }
                bf16* rowp = base + drow * DM + cg0;
#pragma unroll
                for (int bj = 0; bj < 2; ++bj) { pg8::f32x4 v0 = acc[ai][bj][m][0], v1 = acc[ai][bj][m][1];
                    if (act) {
#pragma unroll
                        for (int e = 0; e < 4; ++e) { v0[e] = siluf_(v0[e]); v1[e] = siluf_(v1[e]); } }
                    pg8::u32x4 w; w.x = pg8::cvt_pk_bf16(v0[0], v0[1]); w.y = pg8::cvt_pk_bf16(v0[2], v0[3]); w.z = pg8::cvt_pk_bf16(v1[0], v1[1]); w.w = pg8::cvt_pk_bf16(v1[2], v1[3]);
                    *(pg8::u32x4*)(rowp + bj * 128) = w; }
            }
    }
};
struct Epi2 {
    static constexpr bool PERM = false, AFTER_DRAIN = false;
    const float* x; const float* mod; float* out;
    __device__ __forceinline__ void operator()(const pg8::f32x4 (&acc)[2][2][4][2], const pg8::Unit& u, int wr, int wc, int fr, int fq) const {
        const int row0 = u.pm * 256 + wr * 64 + fr, col0 = u.pn * 256 + wc * 32 + 4 * fq;
        const int b = (u.pm * 256) >> 12;
        const float* gate = mod + (size_t)b * 6144 + 4096;
        pg8::f32x4 gv[2][2];
#pragma unroll
        for (int bj = 0; bj < 2; ++bj)
#pragma unroll
            for (int n = 0; n < 2; ++n) gv[bj][n] = *(const pg8::f32x4*)(gate + col0 + bj * 128 + n * 16);
#pragma unroll
        for (int ai = 0; ai < 2; ++ai)
#pragma unroll
            for (int m = 0; m < 4; ++m) { const size_t off = (size_t)(row0 + ai * 128 + m * 16) * DM + col0;
#pragma unroll
                for (int bj = 0; bj < 2; ++bj)
#pragma unroll
                    for (int n = 0; n < 2; ++n) { const pg8::f32x4 xv = *(const pg8::f32x4*)(x + off + bj * 128 + n * 16);
                        *(pg8::f32x4*)(out + off + bj * 128 + n * 16) = xv + gv[bj][n] * acc[ai][bj][m][n]; } }
    }
};

__device__ __forceinline__ int seq_pos(int dir, int s) { return dir == 0 ? s : (s < CTXL ? CTXL - 1 - s : TT - 1 - (s - CTXL)); }

__device__ __forceinline__ void rglru_naive_item(const Args& a, int b, int n, LAS float* sm) {
    LAS float* U = sm; LAS float* ZR = sm + 2048; LAS float* ZI = sm + 4096;
    const int tid = threadIdx.x;
    const bf16* XA = (const bf16*)(a.ws + WS_XA); const bf16* GA = (const bf16*)(a.ws + WS_GA);
    bf16* TMP = (bf16*)(a.ws + WS_TMPA); bf16* Y = (bf16*)(a.ws + WS_Y);
    const int c = tid & 127, ch = n * 128 + c;
    const float cw0 = a.in[I_CONVW][0 * DM + ch], cw1 = a.in[I_CONVW][1 * DM + ch], cw2 = a.in[I_CONVW][2 * DM + ch], cw3 = a.in[I_CONVW][3 * DM + ch], cb = a.in[I_CONVB][ch];
    for (int dir = 0; dir < 2; ++dir) {
        float h = 0.f;
        const float* Wr = a.in[I_WR] + (size_t)(dir * 16 + n) * 128 * 128;
        const float* Wi = a.in[I_WI] + (size_t)(dir * 16 + n) * 128 * 128;
        const float lam = a.in[I_LAM][dir * DM + ch];
        const float sp = (-lam > 20.f) ? -lam : log1pf(__expf(-lam));
        const int gate = tid >> 8, d = tid & 127, half = (tid >> 7) & 1;
        const float gbias = (gate ? a.in[I_BI] : a.in[I_BR])[dir * DM + n * 128 + d];
        const float* W = gate ? Wi : Wr;
        for (int tile = 0; tile < TT / 16; ++tile) {
#pragma unroll
            for (int j = 0; j < 4; ++j) {
                const int i = (tid >> 7) + 4 * j, s = tile * 16 + i, pos = seq_pos(dir, s);
                const int lo = (s < CTXL) ? 0 : CTXL, hi = (s < CTXL) ? CTXL : TT;
                const bf16* xp = XA + ((size_t)b * TT) * DM + ch;
                float acc = cb;
                if (pos - 2 >= lo) acc += bf2f(xp[(size_t)(pos - 2) * DM]) * cw0;
                if (pos - 1 >= lo) acc += bf2f(xp[(size_t)(pos - 1) * DM]) * cw1;
                acc += bf2f(xp[(size_t)pos * DM]) * cw2;
                if (pos + 1 < hi) acc += bf2f(xp[(size_t)(pos + 1) * DM]) * cw3;
                U[i * 128 + c] = acc;
            }
            __syncthreads();
            {
                float z[8];
#pragma unroll
                for (int i8 = 0; i8 < 8; ++i8) z[i8] = gbias;
                for (int cc = 0; cc < 128; ++cc) { const float w = W[cc * 128 + d];
#pragma unroll
                    for (int i8 = 0; i8 < 8; ++i8) z[i8] += U[(half * 8 + i8) * 128 + cc] * w; }
                LAS float* Z = gate ? ZI : ZR;
#pragma unroll
                for (int i8 = 0; i8 < 8; ++i8) Z[(half * 8 + i8) * 128 + d] = sigmoidf_(z[i8]);
            }
            __syncthreads();
            if (tid < 128) {
                for (int i = 0; i < 16; ++i) {
                    const float r = ZR[i * 128 + c], ig = ZI[i * 128 + c], u = U[i * 128 + c];
                    const float log_a = -8.0f * r * sp;
                    const float av = __expf(log_a);
                    const float bx = sqrtf(fmaxf(-expm1f(2.0f * log_a), 0.f)) * (ig * u);
                    h = av * h + bx;
                    const int s = tile * 16 + i;
                    if (s >= CTXL) { const int t = seq_pos(dir, s) - CTXL; const size_t idx = ((size_t)b * SEQ + t) * DM + ch;
                        if (dir == 0) TMP[idx] = (bf16)f2bf(h);
                        else { const float y = (bf2f(TMP[idx]) + h) * bf2f(GA[idx]); Y[((size_t)b * SEQ + t) * DMIX + ch] = (bf16)f2bf(y); } }
                }
            }
            __syncthreads();
        }
    }
}

__device__ __forceinline__ void hgrn_naive_item(const Args& a, int b, int hd, LAS float* sm) {
    LAS float* Fm = sm; LAS float* Qm = sm + 2048; LAS float* Vm = sm + 4096; LAS float* RED = sm + 6144;
    const int tid = threadIdx.x, lane = tid & 63, wave = tid >> 6;
    const bf16* Qg = (const bf16*)(a.ws + WS_Q); const bf16* Vg = (const bf16*)(a.ws + WS_V); const bf16* GB = (const bf16*)(a.ws + WS_GB);
    bf16* TMP = (bf16*)(a.ws + WS_TMPB); bf16* Y = (bf16*)(a.ws + WS_Y);
    const int v = tid & 127, kq = tid >> 7;
    for (int dir = 0; dir < 2; ++dir) {
        const bf16* Fg = (const bf16*)(a.ws + (dir ? WS_FB : WS_FF));
        float S[32];
#pragma unroll
        for (int kk = 0; kk < 32; ++kk) S[kk] = 0.f;
        const int kch = hd * 128 + (tid & 127);
        const float l0 = a.in[I_LB][(dir * 2 + 0) * DM + kch], l1 = a.in[I_LB][(dir * 2 + 1) * DM + kch];
        const float lb = sigmoidf_(l0 - l1);
        for (int tile = 0; tile < TT / 16; ++tile) {
#pragma unroll
            for (int j = 0; j < 4; ++j) {
                const int i = (tid >> 7) + 4 * j, s = tile * 16 + i, pos = seq_pos(dir, s);
                const size_t ridx = ((size_t)b * TT + pos) * DM + kch;
                const float fpre = bf2f(Fg[ridx]);
                Fm[i * 128 + (tid & 127)] = lb + (1.0f - lb) * sigmoidf_(fpre);
                Vm[i * 128 + (tid & 127)] = bf2f(Vg[ridx]);
                Qm[i * 128 + (tid & 127)] = (s >= CTXL) ? bf2f(Qg[((size_t)b * SEQ + pos - CTXL) * DM + kch]) : 0.f;
            }
            __syncthreads();
            for (int i = 0; i < 16; ++i) {
                const float vv = Vm[i * 128 + v]; float part = 0.f;
#pragma unroll
                for (int kk = 0; kk < 32; ++kk) { const int k = kq * 32 + kk; const float f = Fm[i * 128 + k];
                    S[kk] = f * S[kk] + (1.0f - f) * vv; part += Qm[i * 128 + k] * S[kk]; }
                RED[(i * 4 + kq) * 128 + v] = part;
            }
            __syncthreads();
            if (tile >= CTXL / 16) {
#pragma unroll
                for (int ii = 0; ii < 2; ++ii) {
                    const int i = wave * 2 + ii, s = tile * 16 + i, j = seq_pos(dir, s) - CTXL;
                    float o[2];
#pragma unroll
                    for (int e = 0; e < 2; ++e) { const int vv = lane + 64 * e; o[e] = RED[(i * 4 + 0) * 128 + vv] + RED[(i * 4 + 1) * 128 + vv] + RED[(i * 4 + 2) * 128 + vv] + RED[(i * 4 + 3) * 128 + vv]; }
                    const size_t idx = ((size_t)b * SEQ + j) * DM + hd * 128 + lane;
                    if (dir == 0) { TMP[idx] = (bf16)f2bf(o[0]); TMP[idx + 64] = (bf16)f2bf(o[1]); }
                    else {
                        o[0] += bf2f(TMP[idx]); o[1] += bf2f(TMP[idx + 64]);
                        const float ss = wave_sum(o[0] * o[0] + o[1] * o[1]);
                        const float rs = 1.0f / sqrtf(ss * (1.0f / 128.0f) + EPS);
                        const int t = ((j & 63) << 6) | (j >> 6);
                        const size_t gidx = ((size_t)b * SEQ + t) * DM + hd * 128 + lane;
#pragma unroll
                        for (int e = 0; e < 2; ++e) { const float y = o[e] * rs * a.in[I_HNW][lane + 64 * e] * bf2f(GB[gidx + 64 * e]);
                            Y[((size_t)b * SEQ + t) * DMIX + DM + hd * 128 + lane + 64 * e] = (bf16)f2bf(y); }
                    }
                }
            }
            __syncthreads();
        }
    }
}

__global__ void __launch_bounds__(NTHR, 2) fwd_kernel(Args args) {
    extern __shared__ __attribute__((aligned(16))) unsigned char lds_raw[];
    LAS unsigned char* lds = (LAS unsigned char*)lds_raw;
    volatile LAS unsigned* MISC = (volatile LAS unsigned*)(lds + MISC_OFF);
    const int tid = threadIdx.x, lane = tid & 63, wave = __builtin_amdgcn_readfirstlane(tid >> 6);
    const int G = gridDim.x, bx = blockIdx.x;
    unsigned char* ws = args.ws;
    unsigned* ctl = (unsigned*)(ws + WS_CTL);
    for (int u = tid; u < (LDS_BYTES - LDSCTL_OFF) / 4; u += NTHR) ((LAS unsigned*)(lds + LDSCTL_OFF))[u] = 0u;
    __syncthreads();
    const int lo = args.ph_lo, hi = args.ph_hi;
    const bool fused = (hi - lo) > 1;
    XcdBarrier bar; bar.bar = ctl + CW_BAR; bar.x = 0; bar.st = nullptr;
    if (fused) bar = xcd_barrier_post(ctl + CW_BAR, MISC + 8);
#define IN(k) (lo <= (k) && (k) < hi)
#define BOTH(k) (IN(k) && IN((k) + 1))
#define GRID_BAR() xcd_barrier(bar)

    float* MOD = (float*)(ws + WS_MOD);
    bf16* WIN_T = (bf16*)(ws + WS_WIN); bf16* WOUT_T = (bf16*)(ws + WS_WOUT); bf16* H = (bf16*)(ws + WS_H);

    if (IN(0)) {
        LAS float* SC = (LAS float*)lds;
        LAS float* RED = (LAS float*)(lds + 24576);
        bool sc_ready = false;
        for (int item = bx; item < 192; item += G) {
            if (!sc_ready) {
                for (int i = tid; i < 3 * DM; i += NTHR) { const int v = i / DM, k = i % DM; const float cv = (v < 2) ? args.in[I_C][v * DM + k] : args.in[I_CCTX][k]; SC[i] = siluf_(cv); }
                sc_ready = true;
            }
            __syncthreads();
            float acc[3][4];
#pragma unroll
            for (int v = 0; v < 3; ++v)
#pragma unroll
                for (int e = 0; e < 4; ++e) acc[v][e] = 0.f;
            const float* Wp = args.in[I_ADAW] + (size_t)(wave * 256 + (lane >> 3)) * 6144 + item * 32 + 4 * (lane & 7);
#pragma unroll 8
            for (int it = 0; it < 32; ++it) {
                const f32x4 wv = *(const f32x4*)(Wp + (size_t)it * 8 * 6144);
                const int k = wave * 256 + it * 8 + (lane >> 3);
#pragma unroll
                for (int v = 0; v < 3; ++v) { const float s = SC[v * DM + k];
#pragma unroll
                    for (int e = 0; e < 4; ++e) acc[v][e] += s * wv[e]; }
            }
#pragma unroll
            for (int v = 0; v < 3; ++v)
#pragma unroll
                for (int e = 0; e < 4; ++e) { float x = acc[v][e]; x += __shfl_xor(x, 8); x += __shfl_xor(x, 16); x += __shfl_xor(x, 32); acc[v][e] = x; }
            if (lane < 8) {
#pragma unroll
                for (int v = 0; v < 3; ++v)
#pragma unroll
                    for (int e = 0; e < 4; ++e) RED[(wave * 3 + v) * 32 + 4 * lane + e] = acc[v][e];
            }
            __syncthreads();
            if (tid < 96) { const int v = tid >> 5, col = tid & 31; float s = args.in[I_ADAB][item * 32 + col];
#pragma unroll
                for (int w = 0; w < 8; ++w) s += RED[(w * 3 + v) * 32 + col];
                MOD[v * 6144 + item * 32 + col] = s; }
            __syncthreads();
        }
        __syncthreads();
        LAS float* scr = (LAS float*)(lds + wave * 16384);
        const int gw = bx * NWAVES + wave, NGW = G * NWAVES;
        constexpr int I_1 = (DM / 64) * (INC / 32), I_2 = (DMIX / 64) * (DM / 32);
        for (int it = gw; it < I_1 + I_2; it += NGW) {
            if (it < I_1) p0_transpose_item(args.in[I_WIN], DM, INC, WIN_T, scr, it, lane);
            else p0_transpose_item(args.in[I_WOUT], DMIX, DM, WOUT_T, scr, it - I_1, lane);
        }
        if (BOTH(0)) GRID_BAR();
    }

    if (IN(1)) {
        const int gw = bx * NWAVES + wave, NGW = G * NWAVES;
        for (int R = gw; R < MTOT; R += NGW) {
            const float* src; int mv;
            if (R < MLAT) { src = args.in[I_X] + (size_t)R * DM; mv = R >> 12; } else { src = args.in[I_CTX] + (size_t)(R - MLAT) * DM; mv = 2; }
            const float* shift = MOD + mv * 6144; const float* scale = shift + DM;
            f32x4 v[8]; float ss = 0.f;
#pragma unroll
            for (int j = 0; j < 8; ++j) { v[j] = *(const f32x4*)(src + 4 * lane + 256 * j); ss += (v[j].x * v[j].x + v[j].y * v[j].y) + (v[j].z * v[j].z + v[j].w * v[j].w); }
            const float rs = 1.0f / sqrtf(wave_sum(ss) * (1.0f / DM) + EPS);
            bf16* dst = H + (size_t)R * DM;
#pragma unroll
            for (int j = 0; j < 8; ++j) { const int c0 = 4 * lane + 256 * j;
                const f32x4 nw = *(const f32x4*)(args.in[I_NORMW] + c0), sc = *(const f32x4*)(scale + c0), sh = *(const f32x4*)(shift + c0);
                const f32x4 o = (v[j] * rs) * nw * (1.0f + sc) + sh;
                v2u w; w.x = pk2(o.x, o.y); w.y = pk2(o.z, o.w); *(v2u*)(dst + c0) = w; }
        }
        if (BOTH(1)) GRID_BAR();
    }

    if (IN(2)) {
        pg8::Gemm g{H, WIN_T, MTOT, INC, DM}; Order1 S{G, bx};
        Epi1 E{(bf16*)(ws + WS_XA), (bf16*)(ws + WS_GA), (bf16*)(ws + WS_Q), (bf16*)(ws + WS_FF), (bf16*)(ws + WS_FB), (bf16*)(ws + WS_V), (bf16*)(ws + WS_GB)};
        pg8::gemm_phase<Epi1, Order1, true, true>(lds, g, S, E);
        if (BOTH(2)) GRID_BAR();
    }

    if (IN(3)) {
        for (int item = bx; item < 64; item += G) {
            if (item < 32) rglru_naive_item(args, item >> 4, item & 15, (LAS float*)lds);
            else hgrn_naive_item(args, (item - 32) >> 4, (item - 32) & 15, (LAS float*)lds);
            __syncthreads();
        }
        if (BOTH(3)) GRID_BAR();
    }

    if (IN(4)) {
        pg8::Gemm g{(const bf16*)(ws + WS_Y), WOUT_T, MLAT, DM, DMIX}; Order2 S{G, bx};
        Epi2 E{args.in[I_X], MOD, args.out};
        pg8::gemm_phase<Epi2, Order2, false, true>(lds, g, S, E);
        if (BOTH(4)) GRID_BAR();
    }

    if (IN(5)) {
        const int gw = bx * NWAVES + wave, NGW = G * NWAVES;
        for (int R = gw; R < MLAT; R += NGW) {
            float* row = args.out + (size_t)R * DM;
            f32x4 v[8]; float ss = 0.f;
#pragma unroll
            for (int j = 0; j < 8; ++j) { v[j] = *(const f32x4*)(row + 4 * lane + 256 * j); ss += (v[j].x * v[j].x + v[j].y * v[j].y) + (v[j].z * v[j].z + v[j].w * v[j].w); }
            const float rs = 1.0f / sqrtf(wave_sum(ss) * (1.0f / DM) + EPS);
#pragma unroll
            for (int j = 0; j < 8; ++j) { const int c0 = 4 * lane + 256 * j; const f32x4 nw = *(const f32x4*)(args.in[I_FNW] + c0);
                *(f32x4*)(row + c0) = (v[j] * rs) * nw; }
        }
    }
#undef IN
#undef BOTH
#undef GRID_BAR
}

extern "C" void kernel_launch(void* const* d_in, const int* in_sizes, int n_in, void* d_out, int out_size, void* d_ws, size_t ws_size, hipStream_t stream) {
    static int grid = 0;
    if (grid == 0) {
        if (n_in != 19 || out_size != MLAT * DM || ws_size < WS_END) { fprintf(stderr, "kernel_launch: unexpected problem shape (n_in %d out %d ws %zu)\n", n_in, out_size, ws_size); grid = -1; return; }
        int dev = 0, cus = 0, per_cu = 0;
        if (hipGetDevice(&dev) != hipSuccess || hipDeviceGetAttribute(&cus, hipDeviceAttributeMultiprocessorCount, dev) != hipSuccess) { grid = -1; return; }
        if (hipFuncSetAttribute((const void*)fwd_kernel, hipFuncAttributeMaxDynamicSharedMemorySize, LDS_BYTES) != hipSuccess) { fprintf(stderr, "kernel_launch: hipFuncSetAttribute failed\n"); grid = -1; return; }
        if (hipOccupancyMaxActiveBlocksPerMultiprocessor(&per_cu, (const void*)fwd_kernel, NTHR, LDS_BYTES) != hipSuccess || per_cu < 1) { fprintf(stderr, "kernel_launch: occupancy query failed (%d)\n", per_cu); grid = -1; (void)hipGetLastError(); return; }
        grid = cus * 1;
    }
    if (grid < 0) return;
    (void)hipMemsetAsync((char*)d_ws + WS_CTL, 0, CTL_ZERO_BYTES, stream);
    Args a{};
    for (int i = 0; i < 19; ++i) a.in[i] = (const float*)d_in[i];
    a.out = (float*)d_out; a.ws = (unsigned char*)d_ws;
#if MK_N_LAUNCHES == 1
    a.ph_lo = 0; a.ph_hi = NPHASE;
    void* kargs[] = {&a};
    hipError_t e = hipLaunchCooperativeKernel((const void*)fwd_kernel, dim3(grid), dim3(NTHR), kargs, LDS_BYTES, stream);
    if (e != hipSuccess) fprintf(stderr, "cooperative launch failed: %s (grid %d)\n", hipGetErrorString(e), grid);
#else
    for (int p = 0; p < NPHASE; ++p) {
        a.ph_lo = p; a.ph_hi = p + 1;
        hipLaunchKernelGGL(fwd_kernel, dim3(grid), dim3(NTHR), LDS_BYTES, stream, a);
    }
#endif
}
```

```cpp
#include <hip/hip_runtime.h>
#include <hip/hip_cooperative_groups.h>
#include <cstdio>
#include <cstdint>

#ifndef MK_N_LAUNCHES
#define MK_N_LAUNCHES 1
#endif

namespace pg8 {
#define PG8_LAS __attribute__((address_space(3)))
typedef unsigned short bf16_t;
typedef short bf16x8 __attribute__((ext_vector_type(8)));
typedef float f32x4 __attribute__((ext_vector_type(4)));
typedef unsigned u32x4 __attribute__((ext_vector_type(4)));
constexpr int BM = 256, BK = 64, HALF = 128, HTB = HALF * BK * 2, STAGE_BYTES = 8 * HTB, NXCD = 8, WGM = 8;

__host__ __device__ __forceinline__ int lds_byte(int r, int c) { const int st = (r >> 4) * 2 + (c >> 5), rr = r & 15, cc = c & 31, ob = rr * 64 + cc * 2; return st * 1024 + (ob ^ (((ob >> 9) & 1) << 5)); }
__host__ __device__ __forceinline__ void stage_rc(int b, int& R, int& C) { const int st = b / 1024, sb = b % 1024, swz = sb ^ (((sb >> 9) & 1) << 5); R = (st >> 1) * 16 + swz / 64; C = (st & 1) * 32 + (swz % 64) / 2; }
__host__ __device__ __forceinline__ int perm32(int rho) { const int n = rho >> 4, i = rho & 15; return 8 * (i >> 2) + 4 * n + (i & 3); }

struct Unit { int pm, pn; };
struct Gemm { const bf16_t* A; const bf16_t* Bt; int M, N, K; };

__device__ __forceinline__ unsigned cvt_pk_bf16(float lo, float hi) { unsigned r; asm volatile("v_cvt_pk_bf16_f32 %0, %1, %2" : "=v"(r) : "v"(lo), "v"(hi)); return r; }

template <class Epi, class Sched, bool ALIGN_EPI = false, bool SP2 = false>
__device__ __forceinline__ void gemm_phase(PG8_LAS unsigned char* lds, const Gemm g, const Sched& S, const Epi& E) {
    const int tid = threadIdx.x, wid = __builtin_amdgcn_readfirstlane(tid >> 6), lane = tid & 63, wr = wid >> 2, wc = wid & 3, fr = lane & 15, fq = lane >> 4;
    const int K = g.K, nt = K / BK;
    unsigned voffA[2], voffB[2];
#pragma unroll
    for (int i = 0; i < 2; ++i) { int R, C; stage_rc(tid * 16 + i * 8192, R, C); const int Rb = Epi::PERM ? ((R & ~31) + perm32(R & 31)) : R;
        voffA[i] = (unsigned)(R * K + C) * 2u; voffB[i] = (unsigned)(Rb * K + C) * 2u; }
    const size_t kstep = (size_t)(BK * 2);
    const size_t hstep = (size_t)HALF * K * 2;
    const size_t tstep = 2 * hstep;
    const unsigned ldsw = (unsigned)wid * 1024u;
    const int aoff = lds_byte(wr * 64 + fr, fq * 8), boff = lds_byte(wc * 32 + fr, fq * 8);
#define PG8_SA(b, h) (((b) * 2 + (h)) * HTB)
#define PG8_SB(b, h) ((4 + (b) * 2 + (h)) * HTB)
#define PG8_STAGE(bufoff, gbase, voff) do { _Pragma("unroll") for (int _i = 0; _i < 2; ++_i) \
        __builtin_amdgcn_global_load_lds((const unsigned*)((const char*)(gbase) + (voff)[_i]), (PG8_LAS unsigned*)(lds + (bufoff) + ldsw + _i * 8192), 16, 0, 0); } while (0)
#define PG8_LDA(dst, b, h) do { _Pragma("unroll") for (int m = 0; m < 4; ++m) _Pragma("unroll") for (int k = 0; k < 2; ++k) dst[m][k] = *(const PG8_LAS bf16x8*)(lds + PG8_SA(b, h) + aoff + m * 2048 + k * 1024); } while (0)
#define PG8_LDB(dst, b, h) do { _Pragma("unroll") for (int n = 0; n < 2; ++n) _Pragma("unroll") for (int k = 0; k < 2; ++k) dst[n][k] = *(const PG8_LAS bf16x8*)(lds + PG8_SB(b, h) + boff + n * 2048 + k * 1024); } while (0)
#define PG8_MMA(ai, bj, At, Bt) do { __builtin_amdgcn_s_setprio(1); _Pragma("unroll") for (int m = 0; m < 4; ++m) _Pragma("unroll") for (int n = 0; n < 2; ++n) _Pragma("unroll") for (int k = 0; k < 2; ++k) \
        acc[ai][bj][m][n] = __builtin_amdgcn_mfma_f32_16x16x32_bf16(Bt[n][k], At[m][k], acc[ai][bj][m][n], 0, 0, 0); __builtin_amdgcn_s_setprio(0); } while (0)
#define PG8_WAIT_V(n) asm volatile("s_waitcnt vmcnt(" #n ")" ::: "memory")
#define PG8_WAIT_L(n) asm volatile("s_waitcnt lgkmcnt(" #n ")" ::: "memory")
#define PG8_BAR __builtin_amdgcn_s_barrier()
#define PG8_SCHED __builtin_amdgcn_sched_barrier(0)
    Unit cur, nxt; int ui = 0;
    if (!S.next(0, cur)) return;
    f32x4 acc[2][2][4][2];
#pragma unroll
    for (int a = 0; a < 2; ++a)
#pragma unroll
        for (int b = 0; b < 2; ++b)
#pragma unroll
            for (int m = 0; m < 4; ++m)
#pragma unroll
                for (int n = 0; n < 2; ++n) acc[a][b][m][n] = (f32x4){0.f, 0.f, 0.f, 0.f};
    bf16x8 At[4][2], B0[2][2], B1[2][2];
    const char* cA = (const char*)g.A + (size_t)cur.pm * tstep; const char* cB = (const char*)g.Bt + (size_t)cur.pn * tstep;
    S.a_ready(cur);
    if constexpr (SP2) {
        PG8_STAGE(PG8_SB(0, 0), cB, voffB); PG8_STAGE(PG8_SB(0, 1), cB + hstep, voffB); PG8_STAGE(PG8_SA(0, 0), cA, voffA); PG8_STAGE(PG8_SA(0, 1), cA + hstep, voffA);
        if (wr == 1) PG8_BAR;
        PG8_WAIT_V(2); PG8_BAR;
        PG8_STAGE(PG8_SB(1, 0), cB + kstep, voffB); PG8_STAGE(PG8_SA(1, 0), cA + kstep, voffA); PG8_STAGE(PG8_SB(1, 1), cB + hstep + kstep, voffB);
        PG8_WAIT_V(6); PG8_BAR;
    } else {
        PG8_STAGE(PG8_SB(0, 0), cB, voffB); PG8_STAGE(PG8_SA(0, 0), cA, voffA); PG8_STAGE(PG8_SB(0, 1), cB + hstep, voffB); PG8_STAGE(PG8_SA(0, 1), cA + hstep, voffA);
        if (wr == 1) PG8_BAR;
        PG8_WAIT_V(4); PG8_BAR;
        PG8_STAGE(PG8_SB(1, 0), cB + kstep, voffB); PG8_STAGE(PG8_SA(1, 0), cA + kstep, voffA); PG8_STAGE(PG8_SB(1, 1), cB + hstep + kstep, voffB);
        PG8_WAIT_V(6); PG8_BAR;
    }
    for (;;) {
        const bool has_next = S.next(ui + 1, nxt);
        const char* nA = has_next ? (const char*)g.A + (size_t)nxt.pm * tstep : cA; const char* nB = has_next ? (const char*)g.Bt + (size_t)nxt.pn * tstep : cB;
        for (int t = 0; t < nt; t += 2) {
            const bool last = (t == nt - 2);
            const char* a1 = cA + (size_t)(t + 1) * kstep;
            const char* a2 = last ? nA : cA + (size_t)(t + 2) * kstep; const char* b2 = last ? nB : cB + (size_t)(t + 2) * kstep;
            const char* a3 = a2 + kstep; const char* b3 = b2 + kstep;
            if (last && has_next) S.a_ready(nxt);
            if constexpr (SP2) {
            PG8_LDB(B0, 0, 0); PG8_LDB(B1, 0, 1); PG8_SCHED; PG8_LDA(At, 0, 0); PG8_STAGE(PG8_SA(1, 1), a1 + hstep, voffA);
            PG8_WAIT_V(8); PG8_WAIT_L(0); PG8_BAR; PG8_MMA(0, 0, At, B0); PG8_MMA(0, 1, At, B1); PG8_BAR; PG8_SCHED;
            PG8_LDA(At, 0, 1); PG8_STAGE(PG8_SB(0, 0), b2, voffB); PG8_STAGE(PG8_SB(0, 1), b2 + hstep, voffB); PG8_STAGE(PG8_SA(0, 0), a2, voffA);
            PG8_WAIT_V(8); PG8_WAIT_L(0); PG8_BAR; PG8_MMA(1, 0, At, B0); PG8_MMA(1, 1, At, B1); PG8_BAR; PG8_SCHED;
            PG8_LDB(B0, 1, 0); PG8_LDB(B1, 1, 1); PG8_SCHED; PG8_LDA(At, 1, 0); PG8_STAGE(PG8_SA(0, 1), a2 + hstep, voffA);
            PG8_WAIT_V(8); PG8_WAIT_L(0); PG8_BAR; PG8_MMA(0, 0, At, B0); PG8_MMA(0, 1, At, B1); PG8_BAR; PG8_SCHED;
            PG8_LDA(At, 1, 1); PG8_STAGE(PG8_SB(1, 0), b3, voffB); PG8_STAGE(PG8_SB(1, 1), b3 + hstep, voffB); PG8_STAGE(PG8_SA(1, 0), a3, voffA);
            PG8_WAIT_V(8); PG8_WAIT_L(0); PG8_BAR; PG8_MMA(1, 0, At, B0); PG8_MMA(1, 1, At, B1); PG8_BAR; PG8_SCHED;
            } else {
            PG8_LDB(B0, 0, 0); PG8_SCHED; PG8_LDA(At, 0, 0); PG8_STAGE(PG8_SA(1, 1), a1 + hstep, voffA);
            PG8_WAIT_L(8); PG8_BAR; PG8_WAIT_L(0); PG8_MMA(0, 0, At, B0); PG8_BAR; PG8_SCHED;
            PG8_LDB(B1, 0, 1); PG8_STAGE(PG8_SB(0, 0), b2, voffB);
            PG8_BAR; PG8_WAIT_L(0); PG8_MMA(0, 1, At, B1); PG8_BAR;
            PG8_LDA(At, 0, 1); PG8_STAGE(PG8_SA(0, 0), a2, voffA);
            PG8_BAR; PG8_WAIT_L(0); PG8_MMA(1, 0, At, B0); PG8_BAR; PG8_SCHED;
            PG8_STAGE(PG8_SB(0, 1), b2 + hstep, voffB);
            PG8_WAIT_V(6); PG8_BAR; PG8_MMA(1, 1, At, B1); PG8_BAR;
            PG8_LDB(B0, 1, 0); PG8_SCHED; PG8_LDA(At, 1, 0); PG8_STAGE(PG8_SA(0, 1), a2 + hstep, voffA);
            PG8_WAIT_L(8); PG8_BAR; PG8_WAIT_L(0); PG8_MMA(0, 0, At, B0); PG8_BAR; PG8_SCHED;
            PG8_LDB(B1, 1, 1); PG8_STAGE(PG8_SB(1, 0), b3, voffB);
            PG8_BAR; PG8_WAIT_L(0); PG8_MMA(0, 1, At, B1); PG8_BAR;
            PG8_LDA(At, 1, 1); PG8_STAGE(PG8_SA(1, 0), a3, voffA);
            PG8_BAR; PG8_WAIT_L(0); PG8_MMA(1, 0, At, B0); PG8_BAR; PG8_SCHED;
            PG8_STAGE(PG8_SB(1, 1), b3 + hstep, voffB);
            PG8_WAIT_V(6); PG8_BAR; PG8_MMA(1, 1, At, B1); PG8_BAR;
            }
        }
        if constexpr (ALIGN_EPI) { if (wr == 0) PG8_BAR; }
        E(acc, cur, wr, wc, fr, fq); S.done(cur);
        if (!has_next) break;
#pragma unroll
        for (int a = 0; a < 2; ++a)
#pragma unroll
            for (int b = 0; b < 2; ++b)
#pragma unroll
                for (int m = 0; m < 4; ++m)
#pragma unroll
                    for (int n = 0; n < 2; ++n) acc[a][b][m][n] = (f32x4){0.f, 0.f, 0.f, 0.f};
        cur = nxt; cA = nA; cB = nB; ++ui;
        if constexpr (ALIGN_EPI) { if (wr == 1) PG8_BAR; }
    }
    PG8_WAIT_V(0);
    if constexpr (!ALIGN_EPI) { if (wr == 0) PG8_BAR; }
    PG8_BAR;
#undef PG8_SA
#undef PG8_SB
#undef PG8_STAGE
#undef PG8_LDA
#undef PG8_LDB
#undef PG8_MMA
#undef PG8_WAIT_V
#undef PG8_WAIT_L
#undef PG8_BAR
#undef PG8_SCHED
}
}

constexpr int NWAVES = 8, NTHR = 512;
constexpr int DM = 2048, SEQ = 4096, CTXL = 256, NBATCH = 2, TT = CTXL + SEQ;
constexpr int MLAT = NBATCH * SEQ, MCTX = NBATCH * CTXL, MTOT = MLAT + MCTX;
constexpr int INC = 7 * DM;
constexpr int DMIX = 2 * DM;
constexpr float EPS = 1e-6f;
constexpr int NPHASE = 7;

constexpr size_t MiB = 1u << 20;
constexpr size_t WS_CTL = 0, CTL_ZERO_BYTES = 1 * MiB;
constexpr size_t WS_MOD = 1 * MiB;
constexpr size_t WS_LRUW = 2 * MiB;
constexpr size_t WS_WOUT = 4 * MiB;
constexpr size_t WS_WIN = 20 * MiB;
constexpr size_t WS_H = 76 * MiB;
constexpr size_t WS_XA = 110 * MiB;
constexpr size_t WS_FF = 144 * MiB;
constexpr size_t WS_FB = 178 * MiB;
constexpr size_t WS_V = 212 * MiB;
constexpr size_t WS_GA = 246 * MiB;
constexpr size_t WS_Q = 278 * MiB;
constexpr size_t WS_GB = 310 * MiB;
constexpr size_t WS_Y = 342 * MiB;
constexpr size_t WS_TMPA = 20 * MiB;
constexpr size_t WS_TMPB = 52 * MiB;
constexpr size_t WS_AGG = 84 * MiB;
constexpr size_t WS_HST = 406 * MiB;
constexpr size_t WS_HDD = 438 * MiB;
constexpr size_t WS_END = 440 * MiB;

constexpr int CW_BAR = 4096;

constexpr int RING_BYTES = 131072;
constexpr int LDSCTL_OFF = RING_BYTES, MISC_OFF = LDSCTL_OFF + 320;
constexpr int LDS_BYTES = 147456;

#define GAS __attribute__((address_space(1)))
#define LAS __attribute__((address_space(3)))
typedef unsigned short bf16;
typedef unsigned v4u __attribute__((ext_vector_type(4)));
typedef unsigned v2u __attribute__((ext_vector_type(2)));
typedef float f32x4 __attribute__((ext_vector_type(4)));
#define LDS_WAIT() asm volatile("s_waitcnt lgkmcnt(0)" ::: "memory")
#define VM_WAIT() asm volatile("s_waitcnt vmcnt(0)" ::: "memory")
__device__ __forceinline__ unsigned f2bf(float f) { unsigned u = __builtin_bit_cast(unsigned, f); return (u + 0x7fffu + ((u >> 16) & 1u)) >> 16; }
__device__ __forceinline__ unsigned pk2(float lo, float hi) { return f2bf(lo) | (f2bf(hi) << 16); }
__device__ __forceinline__ float bf2f(bf16 b) { return __builtin_bit_cast(float, ((unsigned)b) << 16); }
__device__ __forceinline__ float sigmoidf_(float x) { return 1.0f / (1.0f + __expf(-x)); }
__device__ __forceinline__ float siluf_(float x) { return x / (1.0f + __expf(-x)); }

#define XB_TMO      128
#define XB_XCNT(j)  (256  + 64 * (j))
#define XB_XSUB(j)  (1280 + 64 * (j))
#define XB_XGEN(j)  (2304 + 64 * (j))
#define XB_TOP      3328
#define XB_TOPGEN   3392
#define XCD_BAR_WORDS 3456
#define XB_SPIN_CAP (1u << 18)
__device__ __forceinline__ unsigned xb_ld(unsigned* p)              { return __hip_atomic_load(p, __ATOMIC_RELAXED, __HIP_MEMORY_SCOPE_AGENT); }
__device__ __forceinline__ unsigned xb_add(unsigned* p, unsigned v) { return __hip_atomic_fetch_add(p, v, __ATOMIC_RELAXED, __HIP_MEMORY_SCOPE_AGENT); }
__device__ __forceinline__ unsigned xb_xcc_id() { return (unsigned)__builtin_amdgcn_s_getreg((3 << 11) | 20) & 0xFu; }
#define XB_SPIN(cond, bar) do { unsigned _sp = 0; while (cond) { __builtin_amdgcn_s_sleep(1); \
    if ((++_sp & 255u) == 0u) { if (xb_ld(&(bar)[XB_TMO])) break; if (_sp > XB_SPIN_CAP) { atomicAdd(&(bar)[XB_TMO], 1u); break; } } } } while (0)
struct XcdBarrier { unsigned* bar; unsigned x; volatile LAS unsigned* st; };
__device__ __forceinline__ XcdBarrier xcd_barrier_post(unsigned* bar, volatile LAS unsigned* st) {
    XcdBarrier b; b.bar = bar; b.x = xb_xcc_id(); b.st = st;
    if (threadIdx.x == 0) (void)xb_add(&bar[XB_XCNT(b.x)], 1u);
    return b;
}
__device__ __forceinline__ void xcd_barrier_complete(unsigned* bar, unsigned x, unsigned& nloc, unsigned& nx) {
    const unsigned G = gridDim.x * gridDim.y * gridDim.z;
    unsigned sum, cnt, mine, sp = 0u;
    for (;;) {
        sum = 0u; cnt = 0u; mine = 0u;
#pragma unroll
        for (unsigned j = 0; j < 16; ++j) { const unsigned c = xb_ld(&bar[XB_XCNT(j)]); sum += c; cnt += (c > 0u) ? 1u : 0u; mine = (j == x) ? c : mine; }
        if (sum == G) break;
        __builtin_amdgcn_s_sleep(1);
        if ((++sp & 255u) == 0u) { if (xb_ld(&bar[XB_TMO])) break; if (sp > XB_SPIN_CAP) { atomicAdd(&bar[XB_TMO], 1u); break; } }
    }
    nloc = mine > 0u ? mine : 1u; nx = cnt > 0u ? cnt : 1u;
}
__device__ __forceinline__ void xcd_barrier(const XcdBarrier& b) {
    asm volatile("s_waitcnt vmcnt(0)" ::: "memory");
    __syncthreads();
    if (threadIdx.x == 0) {
        unsigned* bar = b.bar;
        __builtin_amdgcn_s_waitcnt(0);
        unsigned nloc = b.st[0], nx = b.st[1];
        if (nloc == 0u) { xcd_barrier_complete(bar, b.x, nloc, nx); b.st[0] = nloc; b.st[1] = nx; }
        const unsigned old = xb_add(&bar[XB_XSUB(b.x)], 1u);
        const unsigned gen = old / nloc;
        if (old + 1u == (gen + 1u) * nloc) {
            __builtin_amdgcn_fence(__ATOMIC_RELEASE, "agent");
            asm volatile("s_waitcnt vmcnt(0)" ::: "memory");
            const unsigned og = xb_add(&bar[XB_TOP], 1u);
            const unsigned tg = og / nx;
            if (og + 1u == (tg + 1u) * nx) xb_add(&bar[XB_TOPGEN], 1u);
            else XB_SPIN(xb_ld(&bar[XB_TOPGEN]) == tg, bar);
            __builtin_amdgcn_fence(__ATOMIC_ACQUIRE, "agent");
            xb_add(&bar[XB_XGEN(b.x)], 1u);
            asm volatile("s_waitcnt vmcnt(0)" ::: "memory");
        } else {
            XB_SPIN(xb_ld(&bar[XB_XGEN(b.x)]) == gen, bar);
            __builtin_amdgcn_fence(__ATOMIC_ACQUIRE, "agent");
            asm volatile("s_waitcnt vmcnt(0)" ::: "memory");
        }
    }
    __syncthreads();
}

struct Args {
    const float* in[19];
    float* out; unsigned char* ws;
    int ph_lo, ph_hi;
};
enum { I_X = 0, I_C, I_CTX, I_CCTX, I_ADAW, I_ADAB, I_NORMW, I_WIN, I_CONVW, I_CONVB, I_WR, I_BR, I_WI, I_BI, I_LAM, I_LB, I_HNW, I_WOUT, I_FNW };

__device__ __forceinline__ float wave_sum(float v) {
#pragma unroll
    for (int o = 1; o < 64; o <<= 1) v += __shfl_xor(v, o);
    return v;
}

__device__ __forceinline__ void p0_transpose_item(const float* W, int K, int N, bf16* WT, LAS float* scr, int item, int lane) {
    const int nblk = N / 32, kb = item / nblk, nb = item % nblk, k0 = 64 * kb, n0 = 32 * nb;
#pragma unroll 8
    for (int i = 0; i < 32; ++i) { const int kk = 2 * i + (lane >> 5); scr[kk * 33 + (lane & 31)] = W[(size_t)(k0 + kk) * N + n0 + (lane & 31)]; }
    LDS_WAIT(); asm volatile("" ::: "memory");
    const int c = lane & 7;
#pragma unroll
    for (int j = 0; j < 4; ++j) { const int n = (lane >> 3) + 8 * j; const LAS float* s = scr + (8 * c) * 33 + n;
        v4u o; o.x = pk2(s[0 * 33], s[1 * 33]); o.y = pk2(s[2 * 33], s[3 * 33]); o.z = pk2(s[4 * 33], s[5 * 33]); o.w = pk2(s[6 * 33], s[7 * 33]);
        *(GAS v4u*)(WT + (size_t)(n0 + n) * K + k0 + 8 * c) = o; }
    LDS_WAIT(); asm volatile("" ::: "memory");
}

struct Order1 {
    int G, c;
    __device__ __forceinline__ bool next(int i, pg8::Unit& u) const {
        const long L = (long)i * G + c; if (L >= 1856) return false;
        int wgid = (int)L; { const int xcd = wgid % 8, off = wgid / 8; wgid = xcd * 232 + off; }
        if (wgid < 1792) { const int g = wgid / 448, rem = wgid % 448; u.pm = g * 8 + (rem & 7); u.pn = rem >> 3; }
        else { const int w = wgid - 1792; u.pm = 32 + (w & 1); const int pi = w >> 1; u.pn = (pi < 8) ? pi : pi + 16; }
        return true;
    }
    __device__ __forceinline__ void a_ready(const pg8::Unit&) const {}
    __device__ __forceinline__ void done(const pg8::Unit&) const {}
};
struct Order2 {
    int G, c;
    __device__ __forceinline__ bool next(int i, pg8::Unit& u) const {
        const long L = (long)i * G + c; if (L >= 256) return false;
        int wgid = (int)L; { const int xcd = wgid % 8, off = wgid / 8; wgid = xcd * 32 + off; }
        const int g = wgid / 64, rem = wgid % 64; u.pm = g * 8 + (rem & 7); u.pn = rem >> 3;
        return true;
    }
    __device__ __forceinline__ void a_ready(const pg8::Unit&) const {}
    __device__ __forceinline__ void done(const pg8::Unit&) const {}
};

struct Epi1 {
    static constexpr bool PERM = true, AFTER_DRAIN = false;
    bf16 *XA, *GA, *Q, *FF, *FB, *V, *GB;
    __device__ __forceinline__ void operator()(const pg8::f32x4 (&acc)[2][2][4][2], const pg8::Unit& u, int wr, int wc, int fr, int fq) const {
        const int grp = u.pn >> 3;
        const int cg0 = (u.pn & 7) * 256 + wc * 32 + 8 * fq;
        const bool is_ctx = u.pm >= 32;
        bf16* base; int mode;
        switch (grp) {
            case 0: base = XA; mode = 0; break;
            case 1: base = GA; mode = 1; break;
            case 2: base = Q; mode = 2; break;
            case 3: base = FF; mode = 3; break;
            case 4: base = FB; mode = 3; break;
            case 5: base = V; mode = 3; break;
            default: base = GB; mode = 1; break;
        }
        const bool act = (mode == 1 || mode == 2);
#pragma unroll
        for (int ai = 0; ai < 2; ++ai)
#pragma unroll
            for (int m = 0; m < 4; ++m) {
                const int rl = 128 * ai + 64 * wr + 16 * m + fr;
                size_t drow;
                if (is_ctx) { const int R = (u.pm - 32) * 256 + rl; drow = (size_t)(R >> 8) * TT + (R & 255); }
                else { const int R = u.pm * 256 + rl; const int b = R >> 12, t = R & 4095, j = ((t & 63) << 6) | (t >> 6);
                    drow = (mode == 0) ? (size_t)b * TT + CTXL + t : (mode == 1) ? (size_t)R : (mode == 2) ? (size_t)b * SEQ + j : (size_t)b * TT + CTXL + j; }
                bf16* rowp = base + drow * DM + cg0;
#pragma unroll
                for (int bj = 0; bj < 2; ++bj) { pg8::f32x4 v0 = acc[ai][bj][m][0], v1 = acc[ai][bj][m][1];
                    if (act) {
#pragma unroll
                        for (int e = 0; e < 4; ++e) { v0[e] = siluf_(v0[e]); v1[e] = siluf_(v1[e]); } }
                    pg8::u32x4 w; w.x = pg8::cvt_pk_bf16(v0[0], v0[1]); w.y = pg8::cvt_pk_bf16(v0[2], v0[3]); w.z = pg8::cvt_pk_bf16(v1[0], v1[1]); w.w = pg8::cvt_pk_bf16(v1[2], v1[3]);
                    *(pg8::u32x4*)(rowp + bj * 128) = w; }
            }
    }
};
struct Epi2 {
    static constexpr bool PERM = false, AFTER_DRAIN = false;
    const float* x; const float* mod; float* out;
    __device__ __forceinline__ void operator()(const pg8::f32x4 (&acc)[2][2][4][2], const pg8::Unit& u, int wr, int wc, int fr, int fq) const {
        const int row0 = u.pm * 256 + wr * 64 + fr, col0 = u.pn * 256 + wc * 32 + 4 * fq;
        const int b = (u.pm * 256) >> 12;
        const float* gate = mod + (size_t)b * 6144 + 4096;
        pg8::f32x4 gv[2][2];
#pragma unroll
        for (int bj = 0; bj < 2; ++bj)
#pragma unroll
            for (int n = 0; n < 2; ++n) gv[bj][n] = *(const pg8::f32x4*)(gate + col0 + bj * 128 + n * 16);
#pragma unroll
        for (int ai = 0; ai < 2; ++ai)
#pragma unroll
            for (int m = 0; m < 4; ++m) { const size_t off = (size_t)(row0 + ai * 128 + m * 16) * DM + col0;
#pragma unroll
                for (int bj = 0; bj < 2; ++bj)
#pragma unroll
                    for (int n = 0; n < 2; ++n) { const pg8::f32x4 xv = *(const pg8::f32x4*)(x + off + bj * 128 + n * 16);
                        *(pg8::f32x4*)(out + off + bj * 128 + n * 16) = xv + gv[bj][n] * acc[ai][bj][m][n]; } }
    }
};

__device__ __forceinline__ int seq_pos(int dir, int s) { return dir == 0 ? s : (s < CTXL ? CTXL - 1 - s : TT - 1 - (s - CTXL)); }

__device__ __forceinline__ void rglru_naive_item(const Args& a, int b, int n, LAS float* sm) {
    LAS float* U = sm; LAS float* ZR = sm + 2048; LAS float* ZI = sm + 4096;
    const int tid = threadIdx.x;
    const bf16* XA = (const bf16*)(a.ws + WS_XA); const bf16* GA = (const bf16*)(a.ws + WS_GA);
    bf16* TMP = (bf16*)(a.ws + WS_TMPA); bf16* Y = (bf16*)(a.ws + WS_Y);
    const int c = tid & 127, ch = n * 128 + c;
    const float cw0 = a.in[I_CONVW][0 * DM + ch], cw1 = a.in[I_CONVW][1 * DM + ch], cw2 = a.in[I_CONVW][2 * DM + ch], cw3 = a.in[I_CONVW][3 * DM + ch], cb = a.in[I_CONVB][ch];
    for (int dir = 0; dir < 2; ++dir) {
        float h = 0.f;
        const float* Wr = a.in[I_WR] + (size_t)(dir * 16 + n) * 128 * 128;
        const float* Wi = a.in[I_WI] + (size_t)(dir * 16 + n) * 128 * 128;
        const float lam = a.in[I_LAM][dir * DM + ch];
        const float sp = (-lam > 20.f) ? -lam : log1pf(__expf(-lam));
        const int gate = tid >> 8, d = tid & 127, half = (tid >> 7) & 1;
        const float gbias = (gate ? a.in[I_BI] : a.in[I_BR])[dir * DM + n * 128 + d];
        const float* W = gate ? Wi : Wr;
        for (int tile = 0; tile < TT / 16; ++tile) {
#pragma unroll
            for (int j = 0; j < 4; ++j) {
                const int i = (tid >> 7) + 4 * j, s = tile * 16 + i, pos = seq_pos(dir, s);
                const int lo = (s < CTXL) ? 0 : CTXL, hi = (s < CTXL) ? CTXL : TT;
                const bf16* xp = XA + ((size_t)b * TT) * DM + ch;
                float acc = cb;
                if (pos - 2 >= lo) acc += bf2f(xp[(size_t)(pos - 2) * DM]) * cw0;
                if (pos - 1 >= lo) acc += bf2f(xp[(size_t)(pos - 1) * DM]) * cw1;
                acc += bf2f(xp[(size_t)pos * DM]) * cw2;
                if (pos + 1 < hi) acc += bf2f(xp[(size_t)(pos + 1) * DM]) * cw3;
                U[i * 128 + c] = acc;
            }
            __syncthreads();
            {
                float z[8];
#pragma unroll
                for (int i8 = 0; i8 < 8; ++i8) z[i8] = gbias;
                for (int cc = 0; cc < 128; ++cc) { const float w = W[cc * 128 + d];
#pragma unroll
                    for (int i8 = 0; i8 < 8; ++i8) z[i8] += U[(half * 8 + i8) * 128 + cc] * w; }
                LAS float* Z = gate ? ZI : ZR;
#pragma unroll
                for (int i8 = 0; i8 < 8; ++i8) Z[(half * 8 + i8) * 128 + d] = sigmoidf_(z[i8]);
            }
            __syncthreads();
            if (tid < 128) {
                for (int i = 0; i < 16; ++i) {
                    const float r = ZR[i * 128 + c], ig = ZI[i * 128 + c], u = U[i * 128 + c];
                    const float log_a = -8.0f * r * sp;
                    const float av = __expf(log_a);
                    const float bx = sqrtf(fmaxf(-expm1f(2.0f * log_a), 0.f)) * (ig * u);
                    h = av * h + bx;
                    const int s = tile * 16 + i;
                    if (s >= CTXL) { const int t = seq_pos(dir, s) - CTXL; const size_t idx = ((size_t)b * SEQ + t) * DM + ch;
                        if (dir == 0) TMP[idx] = (bf16)f2bf(h);
                        else { const float y = (bf2f(TMP[idx]) + h) * bf2f(GA[idx]); Y[((size_t)b * SEQ + t) * DMIX + ch] = (bf16)f2bf(y); } }
                }
            }
            __syncthreads();
        }
    }
}

__device__ __forceinline__ void hgrn_naive_item(const Args& a, int b, int hd, LAS float* sm) {
    LAS float* Fm = sm; LAS float* Qm = sm + 2048; LAS float* Vm = sm + 4096; LAS float* RED = sm + 6144;
    const int tid = threadIdx.x, lane = tid & 63, wave = tid >> 6;
    const bf16* Qg = (const bf16*)(a.ws + WS_Q); const bf16* Vg = (const bf16*)(a.ws + WS_V); const bf16* GB = (const bf16*)(a.ws + WS_GB);
    bf16* TMP = (bf16*)(a.ws + WS_TMPB); bf16* Y = (bf16*)(a.ws + WS_Y);
    const int v = tid & 127, kq = tid >> 7;
    for (int dir = 0; dir < 2; ++dir) {
        const bf16* Fg = (const bf16*)(a.ws + (dir ? WS_FB : WS_FF));
        float S[32];
#pragma unroll
        for (int kk = 0; kk < 32; ++kk) S[kk] = 0.f;
        const int kch = hd * 128 + (tid & 127);
        const float l0 = a.in[I_LB][(dir * 2 + 0) * DM + kch], l1 = a.in[I_LB][(dir * 2 + 1) * DM + kch];
        const float lb = sigmoidf_(l0 - l1);
        for (int tile = 0; tile < TT / 16; ++tile) {
#pragma unroll
            for (int j = 0; j < 4; ++j) {
                const int i = (tid >> 7) + 4 * j, s = tile * 16 + i, pos = seq_pos(dir, s);
                const size_t ridx = ((size_t)b * TT + pos) * DM + kch;
                const float fpre = bf2f(Fg[ridx]);
                Fm[i * 128 + (tid & 127)] = lb + (1.0f - lb) * sigmoidf_(fpre);
                Vm[i * 128 + (tid & 127)] = bf2f(Vg[ridx]);
                Qm[i * 128 + (tid & 127)] = (s >= CTXL) ? bf2f(Qg[((size_t)b * SEQ + pos - CTXL) * DM + kch]) : 0.f;
            }
            __syncthreads();
            for (int i = 0; i < 16; ++i) {
                const float vv = Vm[i * 128 + v]; float part = 0.f;
#pragma unroll
                for (int kk = 0; kk < 32; ++kk) { const int k = kq * 32 + kk; const float f = Fm[i * 128 + k];
                    S[kk] = f * S[kk] + (1.0f - f) * vv; part += Qm[i * 128 + k] * S[kk]; }
                RED[(i * 4 + kq) * 128 + v] = part;
            }
            __syncthreads();
            if (tile >= CTXL / 16) {
#pragma unroll
                for (int ii = 0; ii < 2; ++ii) {
                    const int i = wave * 2 + ii, s = tile * 16 + i, j = seq_pos(dir, s) - CTXL;
                    float o[2];
#pragma unroll
                    for (int e = 0; e < 2; ++e) { const int vv = lane + 64 * e; o[e] = RED[(i * 4 + 0) * 128 + vv] + RED[(i * 4 + 1) * 128 + vv] + RED[(i * 4 + 2) * 128 + vv] + RED[(i * 4 + 3) * 128 + vv]; }
                    const size_t idx = ((size_t)b * SEQ + j) * DM + hd * 128 + lane;
                    if (dir == 0) { TMP[idx] = (bf16)f2bf(o[0]); TMP[idx + 64] = (bf16)f2bf(o[1]); }
                    else {
                        o[0] += bf2f(TMP[idx]); o[1] += bf2f(TMP[idx + 64]);
                        const float ss = wave_sum(o[0] * o[0] + o[1] * o[1]);
                        const float rs = 1.0f / sqrtf(ss * (1.0f / 128.0f) + EPS);
                        const int t = ((j & 63) << 6) | (j >> 6);
                        const size_t gidx = ((size_t)b * SEQ + t) * DM + hd * 128 + lane;
#pragma unroll
                        for (int e = 0; e < 2; ++e) { const float y = o[e] * rs * a.in[I_HNW][lane + 64 * e] * bf2f(GB[gidx + 64 * e]);
                            Y[((size_t)b * SEQ + t) * DMIX + DM + hd * 128 + lane + 64 * e] = (bf16)f2bf(y); }
                    }
                }
            }
            __syncthreads();
        }
    }
}

typedef float f32x16 __attribute__((ext_vector_type(16)));
typedef short s16x8 __attribute__((ext_vector_type(8)));
typedef short s16x4 __attribute__((ext_vector_type(4)));
typedef float f32x2_t __attribute__((ext_vector_type(2)));
typedef __bf16 bf16x2_t __attribute__((ext_vector_type(2)));
__device__ __forceinline__ unsigned cvtpk(float lo, float hi) { f32x2_t v = {lo, hi}; bf16x2_t b = __builtin_convertvector(v, bf16x2_t); return __builtin_bit_cast(unsigned, b); }
__device__ __forceinline__ int crow(int r, int hi) { return (r & 3) + 8 * (r >> 2) + 4 * hi; }
template <int S> __device__ __forceinline__ s16x8 pack8(const f32x16& x) {
    v4u p; p.x = cvtpk(x[8 * S + 0], x[8 * S + 1]); p.y = cvtpk(x[8 * S + 2], x[8 * S + 3]); p.z = cvtpk(x[8 * S + 4], x[8 * S + 5]); p.w = cvtpk(x[8 * S + 6], x[8 * S + 7]);
    return __builtin_bit_cast(s16x8, p);
}
typedef short v4i16_t __attribute__((ext_vector_type(4)));
__device__ __forceinline__ s16x4 ldtr(LAS const unsigned char* p) { return __builtin_bit_cast(s16x4, __builtin_amdgcn_ds_read_tr16_b64_v4i16((LAS v4i16_t*)p)); }
__device__ __forceinline__ s16x8 cat8(s16x4 a, s16x4 b) { return __builtin_shufflevector(a, b, 0, 1, 2, 3, 4, 5, 6, 7); }
#define MFMA32(a, b, c) __builtin_amdgcn_mfma_f32_32x32x16_bf16((a), (b), (c), 0, 0, 0)

constexpr int HG_QROW = 264, HG_KROW = 272, HG_VROW = 320, HG_RROW = 256;
constexpr int HG_QT = 0, HG_KT = 8448, HG_VT = 17152, HG_FAC = 27392, HG_RL = 27904, HG_OST = 28928, HG_RF = 46080, HG_RQ = 54272, HG_DIRB = 62464;
constexpr int HG_OROW = 132;
static_assert(2 * HG_DIRB <= RING_BYTES, "HGRN LDS");
__device__ __forceinline__ int hg_slot(int r) { return r < 16 ? 15 - r : r; }

struct HgrnJob {
    int b, hd;
    int n_ctx;
    int n_lat;
    int jcf, jcb;
    int output;
    int nfold0, nfold1;
    const float* foldS; const float* foldD;
    float* outS0; float* outS1;
    float* outD0; float* outD1;
};

__device__ __forceinline__ void hgrn_run(const Args& a, const HgrnJob& J, LAS unsigned char* lds) {
    const int tid = threadIdx.x, lane = tid & 63, wave = __builtin_amdgcn_readfirstlane(tid >> 6);
    const int dir = wave >> 2, vs = wave & 3, h = lane >> 5, l31 = lane & 31, i16 = lane & 15, gidx = (lane >> 4) & 1;
    LAS unsigned char* L = lds + dir * HG_DIRB;
    const int b = J.b, hd = J.hd;
    const bf16* Fg = (const bf16*)(a.ws + (dir ? WS_FB : WS_FF)) + (size_t)b * TT * DM + hd * 128;
    const bf16* Vg = (const bf16*)(a.ws + WS_V) + (size_t)b * TT * DM + hd * 128;
    const bf16* Qg = (const bf16*)(a.ws + WS_Q) + (size_t)b * SEQ * DM + hd * 128;
    const bf16* GB = (const bf16*)(a.ws + WS_GB) + (size_t)b * SEQ * DM + hd * 128;
    bf16* TMP = (bf16*)(a.ws + WS_TMPB) + (size_t)b * SEQ * DM + hd * 128;
    bf16* Y = (bf16*)(a.ws + WS_Y) + (size_t)b * SEQ * DMIX + DM + hd * 128;
    const int pc = vs * 32 + l31;
    const float lb = sigmoidf_(a.in[I_LB][(dir * 2 + 0) * DM + hd * 128 + pc] - a.in[I_LB][(dir * 2 + 1) * DM + hd * 128 + pc]);
    const float oml = 1.0f - lb;
    const int tg = tid & 255, vrow = tg >> 3, vpc = tg & 7;
    const int vslot = hg_slot(vrow);
    const int nsteps = J.n_ctx + J.n_lat;
    const int nfold = dir ? J.nfold1 : J.nfold0;
    float* outS = dir ? J.outS1 : J.outS0;
    float* outD = dir ? J.outD1 : J.outD0;

    f32x16 S[4];
#pragma unroll
    for (int kt = 0; kt < 4; ++kt)
#pragma unroll
        for (int i = 0; i < 16; ++i) S[kt][i] = 0.f;
    for (int k = 0; k < nfold; ++k) {
        const float* p = J.foldS + ((size_t)(dir * 8 + k) * 4 + vs) * 4096 + lane;
        const float* d = J.foldD + (size_t)(dir * 8 + k) * 256;
#pragma unroll
        for (int kt = 0; kt < 4; ++kt)
#pragma unroll
            for (int g = 0; g < 4; ++g) {
                const f32x4 d0 = *(const f32x4*)(d + kt * 32 + 8 * g + 4 * h), d1 = *(const f32x4*)(d + 128 + kt * 32 + 8 * g + 4 * h);
                S[kt][4 * g + 0] = S[kt][4 * g + 0] * (d0.x * d1.x) + p[(kt * 16 + 4 * g + 0) * 64];
                S[kt][4 * g + 1] = S[kt][4 * g + 1] * (d0.y * d1.y) + p[(kt * 16 + 4 * g + 1) * 64];
                S[kt][4 * g + 2] = S[kt][4 * g + 2] * (d0.z * d1.z) + p[(kt * 16 + 4 * g + 2) * 64];
                S[kt][4 * g + 3] = S[kt][4 * g + 3] * (d0.w * d1.w) + p[(kt * 16 + 4 * g + 3) * 64];
            }
    }
    if (h == 1) { ((LAS float*)(L + HG_RL))[128 + pc] = 1.0f; }
    float dprod = 1.0f;

    v4u vr0, vr1;
#define HG_BASE(i) ((i) < J.n_ctx ? (dir ? (224 - 32 * (i)) : 32 * (i)) : CTXL + 32 * (dir ? (J.jcb - ((i) - J.n_ctx)) : (J.jcf + ((i) - J.n_ctx))))
#define HG_LOADV(i) do { const int _base = HG_BASE(i); const int mrow = _base + (dir ? 31 - vrow : vrow); \
        const v4u* vp = (const v4u*)(Vg + (size_t)mrow * DM + vpc * 16); vr0 = vp[0]; vr1 = vp[1]; } while (0)
#define HG_DMA_RAW(i) do { const int _base = HG_BASE(i); const bool _lq = ((i) >= J.n_ctx) && J.output; \
        _Pragma("unroll") for (int k2 = 0; k2 < 2; ++k2) { const int slot = 8 * vs + 4 * k2 + (lane >> 4), tok = hg_slot(slot), mrow = _base + (dir ? 31 - tok : tok); \
            __builtin_amdgcn_global_load_lds((const unsigned*)(Fg + (size_t)mrow * DM + (lane & 15) * 8), (LAS unsigned*)(L + HG_RF + (8 * vs + 4 * k2) * HG_RROW), 16, 0, 0); \
            if (_lq) __builtin_amdgcn_global_load_lds((const unsigned*)(Qg + (size_t)(mrow - CTXL) * DM + (lane & 15) * 8), (LAS unsigned*)(L + HG_RQ + (8 * vs + 4 * k2) * HG_RROW), 16, 0, 0); } } while (0)
    HG_LOADV(0);
    HG_DMA_RAW(0);
    VM_WAIT();
    __syncthreads();
    for (int step = 0; step < nsteps; ++step) {
        const bool lat = step >= J.n_ctx;
        const bool outp = lat && J.output;
        const int base = HG_BASE(step);
        {
            *(LAS v4u*)(L + HG_VT + vslot * HG_VROW + vpc * 32) = vr0;
            *(LAS v4u*)(L + HG_VT + vslot * HG_VROW + vpc * 32 + 16) = vr1;
            const LAS unsigned char* rf = L + HG_RF + (16 * h) * HG_RROW + pc * 2;
            const LAS unsigned char* rq = L + HG_RQ + (16 * h) * HG_RROW + pc * 2;
            LAS unsigned char* wq = L + HG_QT + (16 * h) * HG_QROW + pc * 2;
            LAS unsigned char* wk = L + HG_KT + (16 * h) * HG_KROW + pc * 2;
            float X = 1.0f;
#pragma unroll
            for (int jj = 0; jj < 16; ++jj) {
                const float z = bf2f(*(const LAS unsigned short*)(rf + jj * HG_RROW));
                const float q = outp ? bf2f(*(const LAS unsigned short*)(rq + jj * HG_RROW)) : 0.f;
                const float e = __expf(-z);
                const float sg = __builtin_amdgcn_rcpf(1.0f + e);
                const float f = lb + oml * sg;
                const float kk = oml * (e * sg);
                const float Xn = X * f;
                const float Xu = h ? Xn : X;
                const float rx = __builtin_amdgcn_rcpf(Xu);
                const float qt = q * (h ? Xu : rx);
                const float kt_ = kk * (h ? rx : Xu);
                *(LAS unsigned short*)(wq + jj * HG_QROW) = (unsigned short)f2bf(qt);
                *(LAS unsigned short*)(wk + jj * HG_KROW) = (unsigned short)f2bf(kt_);
                X = Xn;
            }
            dprod *= X;
            if (h == 0) { const float rlp = ((LAS float*)(L + HG_RL))[((step + 1) & 1) * 128 + pc]; ((LAS float*)(L + HG_FAC))[pc] = X * rlp; }
            else ((LAS float*)(L + HG_RL))[(step & 1) * 128 + pc] = X;
        }
        if (step + 1 < nsteps) HG_LOADV(step + 1);
        __syncthreads();
        if (step + 1 < nsteps) HG_DMA_RAW(step + 1);
        {
            const LAS float* FAC = (const LAS float*)(L + HG_FAC);
#pragma unroll
            for (int kt = 0; kt < 4; ++kt)
#pragma unroll
                for (int g = 0; g < 4; ++g) { const f32x4 fv = *(const LAS f32x4*)(FAC + kt * 32 + 8 * g + 4 * h);
                    S[kt][4 * g + 0] *= fv.x; S[kt][4 * g + 1] *= fv.y; S[kt][4 * g + 2] *= fv.z; S[kt][4 * g + 3] *= fv.w; }
            __builtin_amdgcn_sched_barrier(0);
            s16x8 Vf[2];
#pragma unroll
            for (int sp = 0; sp < 2; ++sp) {
                const LAS unsigned char* p0 = L + HG_VT + (16 * sp + 4 * h + (i16 >> 2)) * HG_VROW + (vs * 32 + 16 * gidx + 4 * (i16 & 3)) * 2;
                Vf[sp] = cat8(ldtr(p0), ldtr(p0 + 8 * HG_VROW));
            }
            if (outp) {
                f32x16 o, P;
#pragma unroll
                for (int i = 0; i < 16; ++i) { o[i] = 0.f; P[i] = 0.f; }
#pragma unroll
                for (int kt = 0; kt < 4; ++kt) {
                    const LAS unsigned char* qp = L + HG_QT + l31 * HG_QROW + (kt * 32 + 4 * h) * 2;
                    const LAS unsigned char* kp = L + HG_KT + l31 * HG_KROW + (kt * 32 + 4 * h) * 2;
                    const s16x8 Qf0 = cat8(*(const LAS s16x4*)(qp), *(const LAS s16x4*)(qp + 16));
                    const s16x8 Qf1 = cat8(*(const LAS s16x4*)(qp + 32), *(const LAS s16x4*)(qp + 48));
                    const s16x8 Kf0 = cat8(*(const LAS s16x4*)(kp), *(const LAS s16x4*)(kp + 16));
                    const s16x8 Kf1 = cat8(*(const LAS s16x4*)(kp + 32), *(const LAS s16x4*)(kp + 48));
                    o = MFMA32(pack8<0>(S[kt]), Qf0, o);
                    o = MFMA32(pack8<1>(S[kt]), Qf1, o);
                    P = MFMA32(Kf0, Qf0, P);
                    P = MFMA32(Kf1, Qf1, P);
                    __builtin_amdgcn_sched_barrier(0);
                }
                const int tb = hg_slot(l31);
#pragma unroll
                for (int i = 0; i < 16; ++i) { const int ta = (i < 8) ? 15 - crow(i, h) : crow(i, h); if (ta > tb) P[i] = 0.f; }
                o = MFMA32(Vf[0], pack8<0>(P), o);
                o = MFMA32(Vf[1], pack8<1>(P), o);
                LAS float* OST = (LAS float*)(L + HG_OST);
#pragma unroll
                for (int g = 0; g < 4; ++g) *(LAS f32x4*)(OST + l31 * HG_OROW + vs * 32 + 8 * g + 4 * h) = (f32x4){o[4 * g], o[4 * g + 1], o[4 * g + 2], o[4 * g + 3]};
            }
#pragma unroll
            for (int kt = 0; kt < 4; ++kt) {
#pragma unroll
                for (int sp = 0; sp < 2; ++sp) {
                    const LAS unsigned char* p0 = L + HG_KT + (16 * sp + 4 * h + (i16 >> 2)) * HG_KROW + (kt * 32 + 16 * gidx + 4 * (i16 & 3)) * 2;
                    const s16x8 KTf = cat8(ldtr(p0), ldtr(p0 + 8 * HG_KROW));
                    S[kt] = MFMA32(KTf, Vf[sp], S[kt]);
                }
            }
        }
        VM_WAIT();
        __syncthreads();
        if (outp) {
            const bool second = (step - J.n_ctx) >= (J.n_lat >> 1);
            const LAS float* OST = (const LAS float*)(L + HG_OST);
            const float nw0 = a.in[I_HNW][lane], nw1 = a.in[I_HNW][lane + 64];
#pragma unroll 2
            for (int rr = 0; rr < 8; ++rr) {
                const int sl = vs * 8 + rr, r = hg_slot(sl);
                const int j = base + (dir ? 31 - r : r) - CTXL;
                float o0 = OST[sl * HG_OROW + lane], o1 = OST[sl * HG_OROW + 64 + lane];
                bf16* tp = TMP + (size_t)j * DM + lane;
                if (!second) { tp[0] = (bf16)f2bf(o0); tp[64] = (bf16)f2bf(o1); }
                else {
                    o0 += bf2f(tp[0]); o1 += bf2f(tp[64]);
                    const float ss = wave_sum(o0 * o0 + o1 * o1);
                    const float rs = 1.0f / sqrtf(ss * (1.0f / 128.0f) + EPS);
                    const int t = ((j & 63) << 6) | (j >> 6);
                    const float g0 = bf2f(GB[(size_t)t * DM + lane]), g1 = bf2f(GB[(size_t)t * DM + 64 + lane]);
                    Y[(size_t)t * DMIX + lane] = (bf16)f2bf(o0 * rs * nw0 * g0);
                    Y[(size_t)t * DMIX + 64 + lane] = (bf16)f2bf(o1 * rs * nw1 * g1);
                }
            }
        }
    }
#undef HG_LOADV
#undef HG_BASE
#undef HG_DMA_RAW
    if (outS) {
        const LAS float* RLl = (const LAS float*)(L + HG_RL) + ((nsteps - 1) & 1) * 128;
        float* p = outS + (size_t)vs * 4096 + lane;
#pragma unroll
        for (int kt = 0; kt < 4; ++kt)
#pragma unroll
            for (int i = 0; i < 16; ++i) p[(kt * 16 + i) * 64] = S[kt][i] * RLl[kt * 32 + crow(i, h)];
    }
    if (outD) outD[h * 128 + pc] = dprod;
    __syncthreads();
}

constexpr int RG_UROW = 272;
constexpr int RG_U = 0, RG_HSEG = 17408, RG_CW = 82944, RG_LDS = 85504;
struct RglruJob {
    int b, n;
    int tf, tb;
    int nsteps;
    int pass2;
    int nfold0, nfold1;
    float* aggF; float* aggB;
    const float* agg0;
};

__device__ __forceinline__ void rglru_run(const Args& a, const RglruJob& J, LAS unsigned char* lds) {
    const int tid = threadIdx.x, lane = tid & 63, wave = __builtin_amdgcn_readfirstlane(tid >> 6);
    const int dir = wave >> 2, cq = wave & 3, h = lane >> 5, l31 = lane & 31;
    const int b = J.b, n = J.n;
    const int ch = n * 128 + cq * 32 + l31;
    const bf16* XA = (const bf16*)(a.ws + WS_XA) + (size_t)b * TT * DM + n * 128;
    LAS unsigned char* U = lds + RG_U + dir * (32 * RG_UROW);
    LAS unsigned char* HS = lds + RG_HSEG + dir * 32768;
    LAS float* CW = (LAS float*)(lds + RG_CW);
    if (tid < 128) {
#pragma unroll
        for (int k = 0; k < 4; ++k) CW[k * 128 + tid] = a.in[I_CONVW][k * DM + n * 128 + tid];
        CW[512 + tid] = a.in[I_CONVB][n * 128 + tid];
    }
    s16x8 Br[8], Bi[8];
    {
        const bf16* Wt = (const bf16*)(a.ws + WS_LRUW);
        const bf16* wr = Wt + ((size_t)((dir * 2 + 0) * 16 + n) * 128 + cq * 32 + l31) * 128 + 8 * h;
        const bf16* wi = Wt + ((size_t)((dir * 2 + 1) * 16 + n) * 128 + cq * 32 + l31) * 128 + 8 * h;
#pragma unroll
        for (int ks = 0; ks < 8; ++ks) { Br[ks] = *(const s16x8*)(wr + 16 * ks); Bi[ks] = *(const s16x8*)(wi + 16 * ks); }
    }
    const float br_ = a.in[I_BR][dir * DM + ch], bi_ = a.in[I_BI][dir * DM + ch];
    const float lam = a.in[I_LAM][dir * DM + ch];
    const float sp = (-lam > 20.f) ? -lam : log1pf(__expf(-lam));
    const float cch2 = -8.0f * sp * 1.4426950408889634f;
    float carry = 0.f, Aseg = 1.f, Bseg = 0.f;
    if (J.pass2) {
        const int nf = dir ? J.nfold1 : J.nfold0;
        const float* ag = J.agg0 + (size_t)dir * 34 * 256 + cq * 32 + l31;
        for (int k = 0; k < nf; ++k) carry = ag[k * 256] * carry + ag[k * 256 + 128];
    }
    const int tg = tid & 255, tk0 = tg >> 4, pp = tg & 15;
    const int srow = 16 * ((l31 >> 2) & 1) + 4 * (l31 >> 3) + (l31 & 3);
    __syncthreads();
    for (int step = 0; step < J.nsteps; ++step) {
        const int gt = dir ? J.tb - step : J.tf + step;
        const int lo = gt < 8 ? 0 : CTXL, hi = gt < 8 ? CTXL : TT;
#pragma unroll
        for (int q2 = 0; q2 < 2; ++q2) {
            const int tk = tk0 + 16 * q2, mrow = 32 * gt + tk;
            float u[8];
            { const f32x4 c0 = *(const LAS f32x4*)(CW + 512 + 8 * pp), c1 = *(const LAS f32x4*)(CW + 512 + 8 * pp + 4);
              u[0] = c0.x; u[1] = c0.y; u[2] = c0.z; u[3] = c0.w; u[4] = c1.x; u[5] = c1.y; u[6] = c1.z; u[7] = c1.w; }
#pragma unroll
            for (int k = 0; k < 4; ++k) {
                const int rr = mrow + k - 2;
                if (rr >= lo && rr < hi) {
                    const v4u xv = *(const v4u*)(XA + (size_t)rr * DM + 8 * pp);
                    const f32x4 w0 = *(const LAS f32x4*)(CW + k * 128 + 8 * pp), w1 = *(const LAS f32x4*)(CW + k * 128 + 8 * pp + 4);
                    u[0] += __builtin_bit_cast(float, xv.x << 16) * w0.x; u[1] += __builtin_bit_cast(float, xv.x & 0xffff0000u) * w0.y;
                    u[2] += __builtin_bit_cast(float, xv.y << 16) * w0.z; u[3] += __builtin_bit_cast(float, xv.y & 0xffff0000u) * w0.w;
                    u[4] += __builtin_bit_cast(float, xv.z << 16) * w1.x; u[5] += __builtin_bit_cast(float, xv.z & 0xffff0000u) * w1.y;
                    u[6] += __builtin_bit_cast(float, xv.w << 16) * w1.z; u[7] += __builtin_bit_cast(float, xv.w & 0xffff0000u) * w1.w;
                }
            }
            v4u o; o.x = cvtpk(u[0], u[1]); o.y = cvtpk(u[2], u[3]); o.z = cvtpk(u[4], u[5]); o.w = cvtpk(u[6], u[7]);
            const int sidx = dir ? 31 - tk : tk;
            *(LAS v4u*)(U + sidx * RG_UROW + 16 * pp) = o;
        }
        __syncthreads();
        f32x16 zr, zi;
#pragma unroll
        for (int i = 0; i < 16; ++i) { zr[i] = br_; zi[i] = bi_; }
        {
            const LAS unsigned char* ap = U + srow * RG_UROW + 16 * h;
#pragma unroll
            for (int ks = 0; ks < 8; ++ks) { const s16x8 af = *(const LAS s16x8*)(ap + 32 * ks);
                zr = MFMA32(af, Br[ks], zr); zi = MFMA32(af, Bi[ks], zi); }
        }
        float hl[16], Pp[16];
        {
            const LAS unsigned char* up = U + (16 * h) * RG_UROW + (cq * 32 + l31) * 2;
            float hrun = 0.f, prun = 1.f;
#pragma unroll
            for (int i = 0; i < 16; ++i) {
                const float r = __builtin_amdgcn_rcpf(1.0f + __builtin_amdgcn_exp2f(-1.4426950408889634f * zr[i]));
                const float ig = __builtin_amdgcn_rcpf(1.0f + __builtin_amdgcn_exp2f(-1.4426950408889634f * zi[i]));
                const float av = __builtin_amdgcn_exp2f(cch2 * r);
                const float uu = bf2f(*(const LAS unsigned short*)(up + i * RG_UROW));
                const float bx = __builtin_amdgcn_sqrtf(fmaxf(1.0f - av * av, 0.f)) * (ig * uu);
                hrun = av * hrun + bx; prun *= av;
                hl[i] = hrun; Pp[i] = prun;
            }
        }
        const float pO = __shfl_xor(Pp[15], 32), hO = __shfl_xor(hl[15], 32);
        const float e0 = h ? (hO + pO * carry) : (hl[15] + Pp[15] * carry);
        const float start = h ? e0 : carry;
        const float cout = h ? (hl[15] + Pp[15] * e0) : (hO + pO * e0);
        if (J.pass2) {
            LAS unsigned char* hp = HS + step * 8192 + (16 * h) * 256 + (cq * 32 + l31) * 2;
#pragma unroll
            for (int i = 0; i < 16; ++i) *(LAS unsigned short*)(hp + i * 256) = (unsigned short)f2bf(hl[i] + Pp[i] * start);
        } else {
            const float At = h ? (pO * Pp[15]) : (Pp[15] * pO);
            Aseg *= At;
        }
        carry = cout;
        __syncthreads();
    }
    if (!J.pass2) {
        float* ag = dir ? J.aggB : J.aggF;
        if (h == 0) { ag[cq * 32 + l31] = Aseg; ag[128 + cq * 32 + l31] = carry; }
        (void)Bseg;
    } else {
        const bf16* GA = (const bf16*)(a.ws + WS_GA) + (size_t)b * SEQ * DM + n * 128;
        bf16* Y = (bf16*)(a.ws + WS_Y) + (size_t)b * SEQ * DMIX + n * 128;
        const int t0 = 32 * (J.tf - 8);
#pragma unroll
        for (int q4 = 0; q4 < 4; ++q4) {
            const int task = tid + 512 * q4, ti = task >> 9, tk = (task >> 4) & 31, p = task & 15;
            const v4u hf = *(const LAS v4u*)(lds + RG_HSEG + ti * 8192 + tk * 256 + 16 * p);
            const v4u hb = *(const LAS v4u*)(lds + RG_HSEG + 32768 + (3 - ti) * 8192 + (31 - tk) * 256 + 16 * p);
            const int t = t0 + 32 * ti + tk;
            const v4u gv = *(const v4u*)(GA + (size_t)t * DM + 8 * p);
            v4u o;
#define RG_COMB(HF, HB, GV) cvtpk((__builtin_bit_cast(float, (HF) << 16) + __builtin_bit_cast(float, (HB) << 16)) * __builtin_bit_cast(float, (GV) << 16), \
                                   (__builtin_bit_cast(float, (HF) & 0xffff0000u) + __builtin_bit_cast(float, (HB) & 0xffff0000u)) * __builtin_bit_cast(float, (GV) & 0xffff0000u))
            o.x = RG_COMB(hf.x, hb.x, gv.x); o.y = RG_COMB(hf.y, hb.y, gv.y); o.z = RG_COMB(hf.z, hb.z, gv.z); o.w = RG_COMB(hf.w, hb.w, gv.w);
#undef RG_COMB
            *(v4u*)(Y + (size_t)t * DMIX + 8 * p) = o;
        }
    }
    __syncthreads();
}

__global__ void __launch_bounds__(NTHR, 2) fwd_kernel(Args args) {
    extern __shared__ __attribute__((aligned(16))) unsigned char lds_raw[];
    LAS unsigned char* lds = (LAS unsigned char*)lds_raw;
    volatile LAS unsigned* MISC = (volatile LAS unsigned*)(lds + MISC_OFF);
    const int tid = threadIdx.x, lane = tid & 63, wave = __builtin_amdgcn_readfirstlane(tid >> 6);
    const int G = gridDim.x, bx = blockIdx.x;
    unsigned char* ws = args.ws;
    unsigned* ctl = (unsigned*)(ws + WS_CTL);
    for (int u = tid; u < (LDS_BYTES - LDSCTL_OFF) / 4; u += NTHR) ((LAS unsigned*)(lds + LDSCTL_OFF))[u] = 0u;
    __syncthreads();
    const int lo = args.ph_lo, hi = args.ph_hi;
    const bool fused = (hi - lo) > 1;
    XcdBarrier bar; bar.bar = ctl + CW_BAR; bar.x = 0; bar.st = nullptr;
    if (fused) bar = xcd_barrier_post(ctl + CW_BAR, MISC + 8);
#define IN(k) (lo <= (k) && (k) < hi)
#define BOTH(k) (IN(k) && IN((k) + 1))
#define GRID_BAR() xcd_barrier(bar)

    float* MOD = (float*)(ws + WS_MOD);
    bf16* WIN_T = (bf16*)(ws + WS_WIN); bf16* WOUT_T = (bf16*)(ws + WS_WOUT); bf16* H = (bf16*)(ws + WS_H);

    if (IN(0)) {
        LAS float* SC = (LAS float*)lds;
        LAS float* RED = (LAS float*)(lds + 24576);
        bool sc_ready = false;
        for (int item = bx; item < 192; item += G) {
            if (!sc_ready) {
                for (int i = tid; i < 3 * DM; i += NTHR) { const int v = i / DM, k = i % DM; const float cv = (v < 2) ? args.in[I_C][v * DM + k] : args.in[I_CCTX][k]; SC[i] = siluf_(cv); }
                sc_ready = true;
            }
            __syncthreads();
            float acc[3][4];
#pragma unroll
            for (int v = 0; v < 3; ++v)
#pragma unroll
                for (int e = 0; e < 4; ++e) acc[v][e] = 0.f;
            const float* Wp = args.in[I_ADAW] + (size_t)(wave * 256 + (lane >> 3)) * 6144 + item * 32 + 4 * (lane & 7);
#pragma unroll 8
            for (int it = 0; it < 32; ++it) {
                const f32x4 wv = *(const f32x4*)(Wp + (size_t)it * 8 * 6144);
                const int k = wave * 256 + it * 8 + (lane >> 3);
#pragma unroll
                for (int v = 0; v < 3; ++v) { const float s = SC[v * DM + k];
#pragma unroll
                    for (int e = 0; e < 4; ++e) acc[v][e] += s * wv[e]; }
            }
#pragma unroll
            for (int v = 0; v < 3; ++v)
#pragma unroll
                for (int e = 0; e < 4; ++e) { float x = acc[v][e]; x += __shfl_xor(x, 8); x += __shfl_xor(x, 16); x += __shfl_xor(x, 32); acc[v][e] = x; }
            if (lane < 8) {
#pragma unroll
                for (int v = 0; v < 3; ++v)
#pragma unroll
                    for (int e = 0; e < 4; ++e) RED[(wave * 3 + v) * 32 + 4 * lane + e] = acc[v][e];
            }
            __syncthreads();
            if (tid < 96) { const int v = tid >> 5, col = tid & 31; float s = args.in[I_ADAB][item * 32 + col];
#pragma unroll
                for (int w = 0; w < 8; ++w) s += RED[(w * 3 + v) * 32 + col];
                MOD[v * 6144 + item * 32 + col] = s; }
            __syncthreads();
        }
        __syncthreads();
        LAS float* scr = (LAS float*)(lds + wave * 16384);
        const int gw = bx * NWAVES + wave, NGW = G * NWAVES;
        constexpr int I_1 = (DM / 64) * (INC / 32), I_2 = (DMIX / 64) * (DM / 32), I_3 = 64 * 8;
        for (int it = gw; it < I_1 + I_2 + I_3; it += NGW) {
            if (it < I_1) p0_transpose_item(args.in[I_WIN], DM, INC, WIN_T, scr, it, lane);
            else if (it < I_1 + I_2) p0_transpose_item(args.in[I_WOUT], DMIX, DM, WOUT_T, scr, it - I_1, lane);
            else { const int r = it - I_1 - I_2, m = r >> 3, sub = r & 7, dirn = m >> 1, gate = m & 1;
                p0_transpose_item((gate ? args.in[I_WI] : args.in[I_WR]) + (size_t)dirn * 16384, 128, 128,
                                  (bf16*)(ws + WS_LRUW) + ((size_t)(((dirn >> 4) * 2 + gate) * 16 + (dirn & 15))) * 16384, scr, sub, lane); }
        }
        if (BOTH(0)) GRID_BAR();
    }

    if (IN(1)) {
        const int gw = bx * NWAVES + wave, NGW = G * NWAVES;
        for (int R = gw; R < MTOT; R += NGW) {
            const float* src; int mv;
            if (R < MLAT) { src = args.in[I_X] + (size_t)R * DM; mv = R >> 12; } else { src = args.in[I_CTX] + (size_t)(R - MLAT) * DM; mv = 2; }
            const float* shift = MOD + mv * 6144; const float* scale = shift + DM;
            f32x4 v[8]; float ss = 0.f;
#pragma unroll
            for (int j = 0; j < 8; ++j) { v[j] = *(const f32x4*)(src + 4 * lane + 256 * j); ss += (v[j].x * v[j].x + v[j].y * v[j].y) + (v[j].z * v[j].z + v[j].w * v[j].w); }
            const float rs = 1.0f / sqrtf(wave_sum(ss) * (1.0f / DM) + EPS);
            bf16* dst = H + (size_t)R * DM;
#pragma unroll
            for (int j = 0; j < 8; ++j) { const int c0 = 4 * lane + 256 * j;
                const f32x4 nw = *(const f32x4*)(args.in[I_NORMW] + c0), sc = *(const f32x4*)(scale + c0), sh = *(const f32x4*)(shift + c0);
                const f32x4 o = (v[j] * rs) * nw * (1.0f + sc) + sh;
                v2u w; w.x = pk2(o.x, o.y); w.y = pk2(o.z, o.w); *(v2u*)(dst + c0) = w; }
        }
        if (BOTH(1)) GRID_BAR();
    }

    if (IN(2)) {
        pg8::Gemm g{H, WIN_T, MTOT, INC, DM}; Order1 S{G, bx};
        Epi1 E{(bf16*)(ws + WS_XA), (bf16*)(ws + WS_GA), (bf16*)(ws + WS_Q), (bf16*)(ws + WS_FF), (bf16*)(ws + WS_FB), (bf16*)(ws + WS_V), (bf16*)(ws + WS_GB)};
        pg8::gemm_phase<Epi1, Order1, true, true>(lds, g, S, E);
        if (BOTH(2)) GRID_BAR();
    }

    float* HST = (float*)(ws + WS_HST); float* HDD = (float*)(ws + WS_HDD); float* AGG = (float*)(ws + WS_AGG);
    if (IN(3)) {
        for (int item = bx; item < 256; item += G) {
            const int bh = item >> 3, e = item & 7;
            HgrnJob J{}; J.b = bh >> 4; J.hd = bh & 15; J.output = 0;
            if (e == 0) { J.n_ctx = 8; J.n_lat = 0; } else { J.n_ctx = 0; J.n_lat = 16; J.jcf = 16 * (e - 1); J.jcb = 16 * (8 - e) + 15; }
            J.outS0 = HST + ((size_t)(bh * 2 + 0) * 8 + e) * 16384; J.outS1 = HST + ((size_t)(bh * 2 + 1) * 8 + e) * 16384;
            J.outD0 = HDD + ((size_t)(bh * 2 + 0) * 8 + e) * 256; J.outD1 = HDD + ((size_t)(bh * 2 + 1) * 8 + e) * 256;
            hgrn_run(args, J, lds);
        }
        for (int item = bx; item < 32 * 33; item += G) {
            const int bn = item / 33, e = item % 33;
            RglruJob J{}; J.b = bn >> 4; J.n = bn & 15; J.nsteps = 4; J.pass2 = 0;
            const int sf = e, sb = (e == 0) ? 1 : (e == 1) ? 0 : 35 - e;
            J.tf = 4 * sf; J.tb = 4 * sb + 3;
            J.aggF = AGG + ((size_t)(bn * 2 + 0) * 34 + e) * 256; J.aggB = AGG + ((size_t)(bn * 2 + 1) * 34 + e) * 256;
            rglru_run(args, J, lds);
        }
        if (BOTH(3)) GRID_BAR();
    }

    if (IN(4)) {
        for (int item = bx; item < 256; item += G) {
            const int bh = item >> 3, g = item & 7;
            HgrnJob J{}; J.b = bh >> 4; J.hd = bh & 15; J.output = 1; J.n_ctx = 0; J.n_lat = 16; J.jcf = 16 * g; J.jcb = 16 * g + 15;
            J.nfold0 = g + 1; J.nfold1 = 8 - g; J.foldS = HST + (size_t)bh * 2 * 8 * 16384; J.foldD = HDD + (size_t)bh * 2 * 8 * 256;
            hgrn_run(args, J, lds);
        }
        for (int item = bx; item < 1024; item += G) {
            const int bn = item >> 5, g = item & 31;
            RglruJob J{}; J.b = bn >> 4; J.n = bn & 15; J.nsteps = 4; J.pass2 = 1;
            J.tf = 8 + 4 * g; J.tb = 8 + 4 * g + 3; J.nfold0 = g + 2; J.nfold1 = 33 - g;
            J.agg0 = AGG + (size_t)bn * 2 * 34 * 256;
            rglru_run(args, J, lds);
        }
        if (BOTH(4)) GRID_BAR();
    }

    if (IN(5)) {
        pg8::Gemm g{(const bf16*)(ws + WS_Y), WOUT_T, MLAT, DM, DMIX}; Order2 S{G, bx};
        Epi2 E{args.in[I_X], MOD, args.out};
        pg8::gemm_phase<Epi2, Order2, false, true>(lds, g, S, E);
        if (BOTH(5)) GRID_BAR();
    }

    if (IN(6)) {
        const int gw = bx * NWAVES + wave, NGW = G * NWAVES;
        for (int R = gw; R < MLAT; R += NGW) {
            float* row = args.out + (size_t)R * DM;
            f32x4 v[8]; float ss = 0.f;
#pragma unroll
            for (int j = 0; j < 8; ++j) { v[j] = *(const f32x4*)(row + 4 * lane + 256 * j); ss += (v[j].x * v[j].x + v[j].y * v[j].y) + (v[j].z * v[j].z + v[j].w * v[j].w); }
            const float rs = 1.0f / sqrtf(wave_sum(ss) * (1.0f / DM) + EPS);
#pragma unroll
            for (int j = 0; j < 8; ++j) { const int c0 = 4 * lane + 256 * j; const f32x4 nw = *(const f32x4*)(args.in[I_FNW] + c0);
                *(f32x4*)(row + c0) = (v[j] * rs) * nw; }
        }
    }
#undef IN
#undef BOTH
#undef GRID_BAR
}

extern "C" void kernel_launch(void* const* d_in, const int* in_sizes, int n_in, void* d_out, int out_size, void* d_ws, size_t ws_size, hipStream_t stream) {
    static int grid = 0;
    if (grid == 0) {
        if (n_in != 19 || out_size != MLAT * DM || ws_size < WS_END) { fprintf(stderr, "kernel_launch: unexpected problem shape (n_in %d out %d ws %zu)\n", n_in, out_size, ws_size); grid = -1; return; }
        int dev = 0, cus = 0, per_cu = 0;
        if (hipGetDevice(&dev) != hipSuccess || hipDeviceGetAttribute(&cus, hipDeviceAttributeMultiprocessorCount, dev) != hipSuccess) { grid = -1; return; }
        if (hipFuncSetAttribute((const void*)fwd_kernel, hipFuncAttributeMaxDynamicSharedMemorySize, LDS_BYTES) != hipSuccess) { fprintf(stderr, "kernel_launch: hipFuncSetAttribute failed\n"); grid = -1; return; }
        if (hipOccupancyMaxActiveBlocksPerMultiprocessor(&per_cu, (const void*)fwd_kernel, NTHR, LDS_BYTES) != hipSuccess || per_cu < 1) { fprintf(stderr, "kernel_launch: occupancy query failed (%d)\n", per_cu); grid = -1; (void)hipGetLastError(); return; }
        grid = cus * 1;
    }
    if (grid < 0) return;
    (void)hipMemsetAsync((char*)d_ws + WS_CTL, 0, CTL_ZERO_BYTES, stream);
    Args a{};
    for (int i = 0; i < 19; ++i) a.in[i] = (const float*)d_in[i];
    a.out = (float*)d_out; a.ws = (unsigned char*)d_ws;
#if MK_N_LAUNCHES == 1
    a.ph_lo = 0; a.ph_hi = NPHASE;
    void* kargs[] = {&a};
    hipError_t e = hipLaunchCooperativeKernel((const void*)fwd_kernel, dim3(grid), dim3(NTHR), kargs, LDS_BYTES, stream);
    if (e != hipSuccess) fprintf(stderr, "cooperative launch failed: %s (grid %d)\n", hipGetErrorString(e), grid);
#else
    for (int p = 0; p < NPHASE; ++p) {
        a.ph_lo = p; a.ph_hi = p + 1;
        hipLaunchKernelGGL(fwd_kernel, dim3(grid), dim3(NTHR), LDS_BYTES, stream, a);
    }
#endif
}
```

```cpp
#include <hip/hip_runtime.h>
#include <hip/hip_cooperative_groups.h>
#include <cstdio>
#include <cstdint>

#ifndef REP_PHASE
#define REP_PHASE -1
#endif
#ifndef MK_N_LAUNCHES
#define MK_N_LAUNCHES 1
#endif

namespace pg8 {
#define PG8_LAS __attribute__((address_space(3)))
typedef unsigned short bf16_t;
typedef short bf16x8 __attribute__((ext_vector_type(8)));
typedef float f32x4 __attribute__((ext_vector_type(4)));
typedef unsigned u32x4 __attribute__((ext_vector_type(4)));
constexpr int BM = 256, BK = 64, HALF = 128, HTB = HALF * BK * 2, STAGE_BYTES = 8 * HTB, NXCD = 8, WGM = 8;

__host__ __device__ __forceinline__ int lds_byte(int r, int c) { const int st = (r >> 4) * 2 + (c >> 5), rr = r & 15, cc = c & 31, ob = rr * 64 + cc * 2; return st * 1024 + (ob ^ (((ob >> 9) & 1) << 5)); }
__host__ __device__ __forceinline__ void stage_rc(int b, int& R, int& C) { const int st = b / 1024, sb = b % 1024, swz = sb ^ (((sb >> 9) & 1) << 5); R = (st >> 1) * 16 + swz / 64; C = (st & 1) * 32 + (swz % 64) / 2; }
__host__ __device__ __forceinline__ int perm32(int rho) { const int n = rho >> 4, i = rho & 15; return 8 * (i >> 2) + 4 * n + (i & 3); }

struct Unit { int pm, pn; };
struct Gemm { const bf16_t* A; const bf16_t* Bt; int M, N, K; };

__device__ __forceinline__ unsigned cvt_pk_bf16(float lo, float hi) { unsigned r; asm volatile("v_cvt_pk_bf16_f32 %0, %1, %2" : "=v"(r) : "v"(lo), "v"(hi)); return r; }

template <class Epi, class Sched, bool ALIGN_EPI = false, bool SP2 = false>
__device__ __forceinline__ void gemm_phase(PG8_LAS unsigned char* lds, const Gemm g, const Sched& S, const Epi& E) {
    const int tid = threadIdx.x, wid = __builtin_amdgcn_readfirstlane(tid >> 6), lane = tid & 63, wr = wid >> 2, wc = wid & 3, fr = lane & 15, fq = lane >> 4;
    const int K = g.K, nt = K / BK;
    unsigned voffA[2], voffB[2];
#pragma unroll
    for (int i = 0; i < 2; ++i) { int R, C; stage_rc(tid * 16 + i * 8192, R, C); const int Rb = Epi::PERM ? ((R & ~31) + perm32(R & 31)) : R;
        voffA[i] = (unsigned)(R * K + C) * 2u; voffB[i] = (unsigned)(Rb * K + C) * 2u; }
    const size_t kstep = (size_t)(BK * 2);
    const size_t hstep = (size_t)HALF * K * 2;
    const size_t tstep = 2 * hstep;
    const unsigned ldsw = (unsigned)wid * 1024u;
    const int aoff = lds_byte(wr * 64 + fr, fq * 8), boff = lds_byte(wc * 32 + fr, fq * 8);
#define PG8_SA(b, h) (((b) * 2 + (h)) * HTB)
#define PG8_SB(b, h) ((4 + (b) * 2 + (h)) * HTB)
#define PG8_STAGE(bufoff, gbase, voff) do { _Pragma("unroll") for (int _i = 0; _i < 2; ++_i) \
        __builtin_amdgcn_global_load_lds((const unsigned*)((const char*)(gbase) + (voff)[_i]), (PG8_LAS unsigned*)(lds + (bufoff) + ldsw + _i * 8192), 16, 0, 0); } while (0)
#define PG8_LDA(dst, b, h) do { _Pragma("unroll") for (int m = 0; m < 4; ++m) _Pragma("unroll") for (int k = 0; k < 2; ++k) dst[m][k] = *(const PG8_LAS bf16x8*)(lds + PG8_SA(b, h) + aoff + m * 2048 + k * 1024); } while (0)
#define PG8_LDB(dst, b, h) do { _Pragma("unroll") for (int n = 0; n < 2; ++n) _Pragma("unroll") for (int k = 0; k < 2; ++k) dst[n][k] = *(const PG8_LAS bf16x8*)(lds + PG8_SB(b, h) + boff + n * 2048 + k * 1024); } while (0)
#define PG8_MMA(ai, bj, At, Bt) do { __builtin_amdgcn_s_setprio(1); _Pragma("unroll") for (int m = 0; m < 4; ++m) _Pragma("unroll") for (int n = 0; n < 2; ++n) _Pragma("unroll") for (int k = 0; k < 2; ++k) \
        acc[ai][bj][m][n] = __builtin_amdgcn_mfma_f32_16x16x32_bf16(Bt[n][k], At[m][k], acc[ai][bj][m][n], 0, 0, 0); __builtin_amdgcn_s_setprio(0); } while (0)
#define PG8_WAIT_V(n) asm volatile("s_waitcnt vmcnt(" #n ")" ::: "memory")
#define PG8_WAIT_L(n) asm volatile("s_waitcnt lgkmcnt(" #n ")" ::: "memory")
#define PG8_BAR __builtin_amdgcn_s_barrier()
#define PG8_SCHED __builtin_amdgcn_sched_barrier(0)
    Unit cur, nxt; int ui = 0;
    if (!S.next(0, cur)) return;
    f32x4 acc[2][2][4][2];
#pragma unroll
    for (int a = 0; a < 2; ++a)
#pragma unroll
        for (int b = 0; b < 2; ++b)
#pragma unroll
            for (int m = 0; m < 4; ++m)
#pragma unroll
                for (int n = 0; n < 2; ++n) acc[a][b][m][n] = (f32x4){0.f, 0.f, 0.f, 0.f};
    bf16x8 At[4][2], B0[2][2], B1[2][2];
    const char* cA = (const char*)g.A + (size_t)cur.pm * tstep; const char* cB = (const char*)g.Bt + (size_t)cur.pn * tstep;
    S.a_ready(cur);
    if constexpr (SP2) {
        PG8_STAGE(PG8_SB(0, 0), cB, voffB); PG8_STAGE(PG8_SB(0, 1), cB + hstep, voffB); PG8_STAGE(PG8_SA(0, 0), cA, voffA); PG8_STAGE(PG8_SA(0, 1), cA + hstep, voffA);
        if (wr == 1) PG8_BAR;
        PG8_WAIT_V(2); PG8_BAR;
        PG8_STAGE(PG8_SB(1, 0), cB + kstep, voffB); PG8_STAGE(PG8_SA(1, 0), cA + kstep, voffA); PG8_STAGE(PG8_SB(1, 1), cB + hstep + kstep, voffB);
        PG8_WAIT_V(6); PG8_BAR;
    } else {
        PG8_STAGE(PG8_SB(0, 0), cB, voffB); PG8_STAGE(PG8_SA(0, 0), cA, voffA); PG8_STAGE(PG8_SB(0, 1), cB + hstep, voffB); PG8_STAGE(PG8_SA(0, 1), cA + hstep, voffA);
        if (wr == 1) PG8_BAR;
        PG8_WAIT_V(4); PG8_BAR;
        PG8_STAGE(PG8_SB(1, 0), cB + kstep, voffB); PG8_STAGE(PG8_SA(1, 0), cA + kstep, voffA); PG8_STAGE(PG8_SB(1, 1), cB + hstep + kstep, voffB);
        PG8_WAIT_V(6); PG8_BAR;
    }
    for (;;) {
        const bool has_next = S.next(ui + 1, nxt);
        const char* nA = has_next ? (const char*)g.A + (size_t)nxt.pm * tstep : cA; const char* nB = has_next ? (const char*)g.Bt + (size_t)nxt.pn * tstep : cB;
        for (int t = 0; t < nt; t += 2) {
            const bool last = (t == nt - 2);
            const char* a1 = cA + (size_t)(t + 1) * kstep;
            const char* a2 = last ? nA : cA + (size_t)(t + 2) * kstep; const char* b2 = last ? nB : cB + (size_t)(t + 2) * kstep;
            const char* a3 = a2 + kstep; const char* b3 = b2 + kstep;
            if (last && has_next) S.a_ready(nxt);
            if constexpr (SP2) {
            PG8_LDB(B0, 0, 0); PG8_LDB(B1, 0, 1); PG8_SCHED; PG8_LDA(At, 0, 0); PG8_STAGE(PG8_SA(1, 1), a1 + hstep, voffA);
            PG8_WAIT_V(8); PG8_WAIT_L(0); PG8_BAR; PG8_MMA(0, 0, At, B0); PG8_MMA(0, 1, At, B1); PG8_BAR; PG8_SCHED;
            PG8_LDA(At, 0, 1); PG8_STAGE(PG8_SB(0, 0), b2, voffB); PG8_STAGE(PG8_SB(0, 1), b2 + hstep, voffB); PG8_STAGE(PG8_SA(0, 0), a2, voffA);
            PG8_WAIT_V(8); PG8_WAIT_L(0); PG8_BAR; PG8_MMA(1, 0, At, B0); PG8_MMA(1, 1, At, B1); PG8_BAR; PG8_SCHED;
            PG8_LDB(B0, 1, 0); PG8_LDB(B1, 1, 1); PG8_SCHED; PG8_LDA(At, 1, 0); PG8_STAGE(PG8_SA(0, 1), a2 + hstep, voffA);
            PG8_WAIT_V(8); PG8_WAIT_L(0); PG8_BAR; PG8_MMA(0, 0, At, B0); PG8_MMA(0, 1, At, B1); PG8_BAR; PG8_SCHED;
            PG8_LDA(At, 1, 1); PG8_STAGE(PG8_SB(1, 0), b3, voffB); PG8_STAGE(PG8_SB(1, 1), b3 + hstep, voffB); PG8_STAGE(PG8_SA(1, 0), a3, voffA);
            PG8_WAIT_V(8); PG8_WAIT_L(0); PG8_BAR; PG8_MMA(1, 0, At, B0); PG8_MMA(1, 1, At, B1); PG8_BAR; PG8_SCHED;
            } else {
            PG8_LDB(B0, 0, 0); PG8_SCHED; PG8_LDA(At, 0, 0); PG8_STAGE(PG8_SA(1, 1), a1 + hstep, voffA);
            PG8_WAIT_L(8); PG8_BAR; PG8_WAIT_L(0); PG8_MMA(0, 0, At, B0); PG8_BAR; PG8_SCHED;
            PG8_LDB(B1, 0, 1); PG8_STAGE(PG8_SB(0, 0), b2, voffB);
            PG8_BAR; PG8_WAIT_L(0); PG8_MMA(0, 1, At, B1); PG8_BAR;
            PG8_LDA(At, 0, 1); PG8_STAGE(PG8_SA(0, 0), a2, voffA);
            PG8_BAR; PG8_WAIT_L(0); PG8_MMA(1, 0, At, B0); PG8_BAR; PG8_SCHED;
            PG8_STAGE(PG8_SB(0, 1), b2 + hstep, voffB);
            PG8_WAIT_V(6); PG8_BAR; PG8_MMA(1, 1, At, B1); PG8_BAR;
            PG8_LDB(B0, 1, 0); PG8_SCHED; PG8_LDA(At, 1, 0); PG8_STAGE(PG8_SA(0, 1), a2 + hstep, voffA);
            PG8_WAIT_L(8); PG8_BAR; PG8_WAIT_L(0); PG8_MMA(0, 0, At, B0); PG8_BAR; PG8_SCHED;
            PG8_LDB(B1, 1, 1); PG8_STAGE(PG8_SB(1, 0), b3, voffB);
            PG8_BAR; PG8_WAIT_L(0); PG8_MMA(0, 1, At, B1); PG8_BAR;
            PG8_LDA(At, 1, 1); PG8_STAGE(PG8_SA(1, 0), a3, voffA);
            PG8_BAR; PG8_WAIT_L(0); PG8_MMA(1, 0, At, B0); PG8_BAR; PG8_SCHED;
            PG8_STAGE(PG8_SB(1, 1), b3 + hstep, voffB);
            PG8_WAIT_V(6); PG8_BAR; PG8_MMA(1, 1, At, B1); PG8_BAR;
            }
        }
        if constexpr (ALIGN_EPI) { if (wr == 0) PG8_BAR; }
        E(acc, cur, wr, wc, fr, fq); S.done(cur);
        if (!has_next) break;
#pragma unroll
        for (int a = 0; a < 2; ++a)
#pragma unroll
            for (int b = 0; b < 2; ++b)
#pragma unroll
                for (int m = 0; m < 4; ++m)
#pragma unroll
                    for (int n = 0; n < 2; ++n) acc[a][b][m][n] = (f32x4){0.f, 0.f, 0.f, 0.f};
        cur = nxt; cA = nA; cB = nB; ++ui;
        if constexpr (ALIGN_EPI) { if (wr == 1) PG8_BAR; }
    }
    PG8_WAIT_V(0);
    if constexpr (!ALIGN_EPI) { if (wr == 0) PG8_BAR; }
    PG8_BAR;
#undef PG8_SA
#undef PG8_SB
#undef PG8_STAGE
#undef PG8_LDA
#undef PG8_LDB
#undef PG8_MMA
#undef PG8_WAIT_V
#undef PG8_WAIT_L
#undef PG8_BAR
#undef PG8_SCHED
}
}

constexpr int NWAVES = 8, NTHR = 512;
constexpr int DM = 2048, SEQ = 4096, CTXL = 256, NBATCH = 2, TT = CTXL + SEQ;
constexpr int MLAT = NBATCH * SEQ, MCTX = NBATCH * CTXL, MTOT = MLAT + MCTX;
constexpr int INC = 7 * DM;
constexpr int DMIX = 2 * DM;
constexpr float EPS = 1e-6f;
constexpr int NPHASE = 9;

constexpr size_t MiB = 1u << 20;
constexpr size_t WS_CTL = 0, CTL_ZERO_BYTES = 1 * MiB;
constexpr size_t WS_MOD = 1 * MiB;
constexpr size_t WS_LRUW = 2 * MiB;
constexpr size_t WS_WOUT = 4 * MiB;
constexpr size_t WS_WIN = 20 * MiB;
constexpr size_t WS_H = 76 * MiB;
constexpr size_t WS_XA = 110 * MiB;
constexpr size_t WS_FF = 144 * MiB;
constexpr size_t WS_FB = 178 * MiB;
constexpr size_t WS_V = 212 * MiB;
constexpr size_t WS_GA = 246 * MiB;
constexpr size_t WS_Q = 278 * MiB;
constexpr size_t WS_GB = 310 * MiB;
constexpr size_t WS_Y = 342 * MiB;
constexpr size_t WS_OML = 1 * MiB + 128 * 1024;
constexpr size_t WS_OF = 20 * MiB;
constexpr size_t WS_OB = 52 * MiB;
constexpr size_t WS_AGG = 84 * MiB;
constexpr size_t WS_HST = 406 * MiB;
constexpr size_t WS_HDD = 438 * MiB;
constexpr size_t WS_END = 440 * MiB;

constexpr int CW_BAR = 4096;

constexpr int RING_BYTES = 131072;
constexpr int LDSCTL_OFF = RING_BYTES, MISC_OFF = LDSCTL_OFF + 320;
constexpr int LDS_BYTES = 147456;

#define GAS __attribute__((address_space(1)))
#define LAS __attribute__((address_space(3)))
typedef unsigned short bf16;
typedef unsigned v4u __attribute__((ext_vector_type(4)));
typedef unsigned v2u __attribute__((ext_vector_type(2)));
typedef float f32x4 __attribute__((ext_vector_type(4)));
#define LDS_WAIT() asm volatile("s_waitcnt lgkmcnt(0)" ::: "memory")
#define VM_WAIT() asm volatile("s_waitcnt vmcnt(0)" ::: "memory")
__device__ __forceinline__ unsigned f2bf(float f) { unsigned u = __builtin_bit_cast(unsigned, f); return (u + 0x7fffu + ((u >> 16) & 1u)) >> 16; }
__device__ __forceinline__ unsigned pk2(float lo, float hi) { return f2bf(lo) | (f2bf(hi) << 16); }
__device__ __forceinline__ float bf2f(bf16 b) { return __builtin_bit_cast(float, ((unsigned)b) << 16); }
__device__ __forceinline__ float sigmoidf_(float x) { return 1.0f / (1.0f + __expf(-x)); }
__device__ __forceinline__ float siluf_(float x) { return x / (1.0f + __expf(-x)); }

#define XB_TMO      128
#define XB_XCNT(j)  (256  + 64 * (j))
#define XB_XSUB(j)  (1280 + 64 * (j))
#define XB_XGEN(j)  (2304 + 64 * (j))
#define XB_TOP      3328
#define XB_TOPGEN   3392
#define XCD_BAR_WORDS 3456
#define XB_SPIN_CAP (1u << 18)
__device__ __forceinline__ unsigned xb_ld(unsigned* p)              { return __hip_atomic_load(p, __ATOMIC_RELAXED, __HIP_MEMORY_SCOPE_AGENT); }
__device__ __forceinline__ unsigned xb_add(unsigned* p, unsigned v) { return __hip_atomic_fetch_add(p, v, __ATOMIC_RELAXED, __HIP_MEMORY_SCOPE_AGENT); }
__device__ __forceinline__ unsigned xb_xcc_id() { return (unsigned)__builtin_amdgcn_s_getreg((3 << 11) | 20) & 0xFu; }
#define XB_SPIN(cond, bar) do { unsigned _sp = 0; while (cond) { __builtin_amdgcn_s_sleep(1); \
    if ((++_sp & 255u) == 0u) { if (xb_ld(&(bar)[XB_TMO])) break; if (_sp > XB_SPIN_CAP) { atomicAdd(&(bar)[XB_TMO], 1u); break; } } } } while (0)
struct XcdBarrier { unsigned* bar; unsigned x; volatile LAS unsigned* st; };
__device__ __forceinline__ XcdBarrier xcd_barrier_post(unsigned* bar, volatile LAS unsigned* st) {
    XcdBarrier b; b.bar = bar; b.x = xb_xcc_id(); b.st = st;
    if (threadIdx.x == 0) (void)xb_add(&bar[XB_XCNT(b.x)], 1u);
    return b;
}
__device__ __forceinline__ void xcd_barrier_complete(unsigned* bar, unsigned x, unsigned& nloc, unsigned& nx) {
    const unsigned G = gridDim.x * gridDim.y * gridDim.z;
    unsigned sum, cnt, mine, sp = 0u;
    for (;;) {
        sum = 0u; cnt = 0u; mine = 0u;
#pragma unroll
        for (unsigned j = 0; j < 16; ++j) { const unsigned c = xb_ld(&bar[XB_XCNT(j)]); sum += c; cnt += (c > 0u) ? 1u : 0u; mine = (j == x) ? c : mine; }
        if (sum == G) break;
        __builtin_amdgcn_s_sleep(1);
        if ((++sp & 255u) == 0u) { if (xb_ld(&bar[XB_TMO])) break; if (sp > XB_SPIN_CAP) { atomicAdd(&bar[XB_TMO], 1u); break; } }
    }
    nloc = mine > 0u ? mine : 1u; nx = cnt > 0u ? cnt : 1u;
}
__device__ __forceinline__ void xcd_barrier(const XcdBarrier& b) {
    asm volatile("s_waitcnt vmcnt(0)" ::: "memory");
    __syncthreads();
    if (threadIdx.x == 0) {
        unsigned* bar = b.bar;
        __builtin_amdgcn_s_waitcnt(0);
        unsigned nloc = b.st[0], nx = b.st[1];
        if (nloc == 0u) { xcd_barrier_complete(bar, b.x, nloc, nx); b.st[0] = nloc; b.st[1] = nx; }
        const unsigned old = xb_add(&bar[XB_XSUB(b.x)], 1u);
        const unsigned gen = old / nloc;
        if (old + 1u == (gen + 1u) * nloc) {
            __builtin_amdgcn_fence(__ATOMIC_RELEASE, "agent");
            asm volatile("s_waitcnt vmcnt(0)" ::: "memory");
            const unsigned og = xb_add(&bar[XB_TOP], 1u);
            const unsigned tg = og / nx;
            if (og + 1u == (tg + 1u) * nx) xb_add(&bar[XB_TOPGEN], 1u);
            else XB_SPIN(xb_ld(&bar[XB_TOPGEN]) == tg, bar);
            __builtin_amdgcn_fence(__ATOMIC_ACQUIRE, "agent");
            xb_add(&bar[XB_XGEN(b.x)], 1u);
            asm volatile("s_waitcnt vmcnt(0)" ::: "memory");
        } else {
            XB_SPIN(xb_ld(&bar[XB_XGEN(b.x)]) == gen, bar);
            __builtin_amdgcn_fence(__ATOMIC_ACQUIRE, "agent");
            asm volatile("s_waitcnt vmcnt(0)" ::: "memory");
        }
    }
    __syncthreads();
}

struct Args {
    const float* in[19];
    float* out; unsigned char* ws;
    int ph_lo, ph_hi;
};
enum { I_X = 0, I_C, I_CTX, I_CCTX, I_ADAW, I_ADAB, I_NORMW, I_WIN, I_CONVW, I_CONVB, I_WR, I_BR, I_WI, I_BI, I_LAM, I_LB, I_HNW, I_WOUT, I_FNW };

__device__ __forceinline__ float wave_sum(float v) {
#pragma unroll
    for (int o = 1; o < 64; o <<= 1) v += __shfl_xor(v, o);
    return v;
}

__device__ __forceinline__ void p0_transpose_item(const float* W, int K, int N, bf16* WT, LAS float* scr, int item, int lane, float scale = 1.0f) {
    const int nblk = N / 32, kb = item / nblk, nb = item % nblk, k0 = 64 * kb, n0 = 32 * nb;
#pragma unroll 8
    for (int i = 0; i < 32; ++i) { const int kk = 2 * i + (lane >> 5); scr[kk * 33 + (lane & 31)] = W[(size_t)(k0 + kk) * N + n0 + (lane & 31)] * scale; }
    LDS_WAIT(); asm volatile("" ::: "memory");
    const int c = lane & 7;
#pragma unroll
    for (int j = 0; j < 4; ++j) { const int n = (lane >> 3) + 8 * j; const LAS float* s = scr + (8 * c) * 33 + n;
        v4u o; o.x = pk2(s[0 * 33], s[1 * 33]); o.y = pk2(s[2 * 33], s[3 * 33]); o.z = pk2(s[4 * 33], s[5 * 33]); o.w = pk2(s[6 * 33], s[7 * 33]);
        *(GAS v4u*)(WT + (size_t)(n0 + n) * K + k0 + 8 * c) = o; }
    LDS_WAIT(); asm volatile("" ::: "memory");
}

struct Order1 {
    int G, c;
    __device__ __forceinline__ bool next(int i, pg8::Unit& u) const {
        const long L = (long)i * G + c; if (L >= 1856) return false;
        int wgid = (int)L; { const int xcd = wgid % 8, off = wgid / 8; wgid = xcd * 232 + off; }
        if (wgid < 1792) { const int g = wgid / 448, rem = wgid % 448; u.pm = g * 8 + (rem & 7); u.pn = rem >> 3; }
        else { const int w = wgid - 1792; u.pm = 32 + (w & 1); const int pi = w >> 1; u.pn = (pi < 8) ? pi : pi + 16; }
        return true;
    }
    __device__ __forceinline__ void a_ready(const pg8::Unit&) const {}
    __device__ __forceinline__ void done(const pg8::Unit&) const {}
};
struct Order2 {
    int G, c;
    __device__ __forceinline__ bool next(int i, pg8::Unit& u) const {
        const long L = (long)i * G + c; if (L >= 256) return false;
        int wgid = (int)L; { const int xcd = wgid % 8, off = wgid / 8; wgid = xcd * 32 + off; }
        const int g = wgid / 64, rem = wgid % 64; u.pm = g * 8 + (rem & 7); u.pn = rem >> 3;
        return true;
    }
    __device__ __forceinline__ void a_ready(const pg8::Unit&) const {}
    __device__ __forceinline__ void done(const pg8::Unit&) const {}
};

struct Epi1 {
    static constexpr bool PERM = true, AFTER_DRAIN = false;
    bf16 *XA, *GA, *Q, *FF, *FB, *V, *GB; const float* OML;
    __device__ __forceinline__ void operator()(const pg8::f32x4 (&acc)[2][2][4][2], const pg8::Unit& u, int wr, int wc, int fr, int fq) const {
        const int grp = u.pn >> 3;
        const int cg0 = (u.pn & 7) * 256 + wc * 32 + 8 * fq;
        const bool is_ctx = u.pm >= 32;
        bf16* base; int mode;
        switch (grp) {
            case 0: base = XA; mode = 0; break;
            case 1: base = GA; mode = 1; break;
            case 2: base = Q; mode = 2; break;
            case 3: base = FF; mode = 3; break;
            case 4: base = FB; mode = 3; break;
            case 5: base = V; mode = 3; break;
            default: base = GB; mode = 1; break;
        }
        const bool act = (mode == 1 || mode == 2);
        const bool fgate = (grp == 3 || grp == 4);
        pg8::f32x4 om[2][2];
        if (fgate) {
#pragma unroll
            for (int bj = 0; bj < 2; ++bj) { om[bj][0] = *(const pg8::f32x4*)(OML + (grp - 3) * DM + cg0 + bj * 128); om[bj][1] = *(const pg8::f32x4*)(OML + (grp - 3) * DM + cg0 + bj * 128 + 4); }
        }
#pragma unroll
        for (int ai = 0; ai < 2; ++ai)
#pragma unroll
            for (int m = 0; m < 4; ++m) {
                const int rl = 128 * ai + 64 * wr + 16 * m + fr;
                size_t drow;
                if (is_ctx) { const int R = (u.pm - 32) * 256 + rl; drow = (size_t)(R >> 8) * TT + (R & 255); }
                else { const int R = u.pm * 256 + rl; const int b = R >> 12, t = R & 4095, j = ((t & 63) << 6) | (t >> 6);
                    drow = (mode == 0) ? (size_t)b * TT + CTXL + t : (mode == 1) ? (size_t)R : (mode == 2) ? (size_t)b * SEQ + j : (size_t)b * TT + CTXL + j; }
                bf16* rowp = base + drow * DM + cg0;
#pragma unroll
                for (int bj = 0; bj < 2; ++bj) { pg8::f32x4 v0 = acc[ai][bj][m][0], v1 = acc[ai][bj][m][1];
                    if (act) {
#pragma unroll
                        for (int e = 0; e < 4; ++e) { v0[e] = siluf_(v0[e]); v1[e] = siluf_(v1[e]); } }
                    if (fgate) {
#pragma unroll
                        for (int e = 0; e < 4; ++e) { v0[e] = om[bj][0][e] * __builtin_amdgcn_rcpf(1.0f + __expf(v0[e])); v1[e] = om[bj][1][e] * __builtin_amdgcn_rcpf(1.0f + __expf(v1[e])); } }
                    pg8::u32x4 w; w.x = pg8::cvt_pk_bf16(v0[0], v0[1]); w.y = pg8::cvt_pk_bf16(v0[2], v0[3]); w.z = pg8::cvt_pk_bf16(v1[0], v1[1]); w.w = pg8::cvt_pk_bf16(v1[2], v1[3]);
                    *(pg8::u32x4*)(rowp + bj * 128) = w; }
            }
    }
};
struct Epi2 {
    static constexpr bool PERM = false, AFTER_DRAIN = false;
    const float* x; const float* mod; float* out;
    __device__ __forceinline__ void operator()(const pg8::f32x4 (&acc)[2][2][4][2], const pg8::Unit& u, int wr, int wc, int fr, int fq) const {
        const int row0 = u.pm * 256 + wr * 64 + fr, col0 = u.pn * 256 + wc * 32 + 4 * fq;
        const int b = (u.pm * 256) >> 12;
        const float* gate = mod + (size_t)b * 6144 + 4096;
        pg8::f32x4 gv[2][2];
#pragma unroll
        for (int bj = 0; bj < 2; ++bj)
#pragma unroll
            for (int n = 0; n < 2; ++n) gv[bj][n] = *(const pg8::f32x4*)(gate + col0 + bj * 128 + n * 16);
#pragma unroll
        for (int ai = 0; ai < 2; ++ai)
#pragma unroll
            for (int m = 0; m < 4; ++m) { const size_t off = (size_t)(row0 + ai * 128 + m * 16) * DM + col0;
#pragma unroll
                for (int bj = 0; bj < 2; ++bj)
#pragma unroll
                    for (int n = 0; n < 2; ++n) { const pg8::f32x4 xv = *(const pg8::f32x4*)(x + off + bj * 128 + n * 16);
                        *(pg8::f32x4*)(out + off + bj * 128 + n * 16) = xv + gv[bj][n] * acc[ai][bj][m][n]; } }
    }
};

typedef float f32x16 __attribute__((ext_vector_type(16)));
typedef short s16x8 __attribute__((ext_vector_type(8)));
typedef short s16x4 __attribute__((ext_vector_type(4)));
typedef float f32x2_t __attribute__((ext_vector_type(2)));
typedef __bf16 bf16x2_t __attribute__((ext_vector_type(2)));
__device__ __forceinline__ unsigned cvtpk(float lo, float hi) { f32x2_t v = {lo, hi}; bf16x2_t b = __builtin_convertvector(v, bf16x2_t); return __builtin_bit_cast(unsigned, b); }
__device__ __forceinline__ int crow(int r, int hi) { return (r & 3) + 8 * (r >> 2) + 4 * hi; }
template <int S> __device__ __forceinline__ s16x8 pack8(const f32x16& x) {
    v4u p; p.x = cvtpk(x[8 * S + 0], x[8 * S + 1]); p.y = cvtpk(x[8 * S + 2], x[8 * S + 3]); p.z = cvtpk(x[8 * S + 4], x[8 * S + 5]); p.w = cvtpk(x[8 * S + 6], x[8 * S + 7]);
    return __builtin_bit_cast(s16x8, p);
}
typedef short v4i16_t __attribute__((ext_vector_type(4)));
__device__ __forceinline__ s16x4 ldtr(LAS const unsigned char* p) { return __builtin_bit_cast(s16x4, __builtin_amdgcn_ds_read_tr16_b64_v4i16((LAS v4i16_t*)p)); }
__device__ __forceinline__ s16x8 cat8(s16x4 a, s16x4 b) { return __builtin_shufflevector(a, b, 0, 1, 2, 3, 4, 5, 6, 7); }
#define MFMA32(a, b, c) __builtin_amdgcn_mfma_f32_32x32x16_bf16((a), (b), (c), 0, 0, 0)

constexpr int HG_QROW = 264, HG_KROW = 272, HG_VROW = 320, HG_RROW = 256;
constexpr int HG_QT = 0, HG_KT = 8448, HG_VT = 17152, HG_FAC = 27392, HG_RL = 27904, HG_OST = 28928, HG_RF = 46080, HG_RQ = 54272, HG_DIRB = 62464;
constexpr int HG_OROW = 132;
static_assert(2 * HG_DIRB <= RING_BYTES, "HGRN LDS");
__device__ __forceinline__ int hg_slot(int r) { return r < 16 ? 15 - r : r; }

struct HgrnJob {
    int b, hd;
    int n_ctx;
    int n_lat;
    int jcf, jcb;
    int output;
    int nfold0, nfold1;
    const float* foldS; const float* foldD;
    float* outS0; float* outS1;
    float* outD0; float* outD1;
};

__device__ __forceinline__ void hgrn_run(const Args& a, const HgrnJob& J, LAS unsigned char* lds) {
    const int tid = threadIdx.x, lane = tid & 63, wave = __builtin_amdgcn_readfirstlane(tid >> 6);
    const int dir = wave >> 2, vs = wave & 3, h = lane >> 5, l31 = lane & 31, i16 = lane & 15, gidx = (lane >> 4) & 1;
    LAS unsigned char* L = lds + dir * HG_DIRB;
    const int b = J.b, hd = J.hd;
    const bf16* Fg = (const bf16*)(a.ws + (dir ? WS_FB : WS_FF)) + (size_t)b * TT * DM + hd * 128;
    const bf16* Vg = (const bf16*)(a.ws + WS_V) + (size_t)b * TT * DM + hd * 128;
    const bf16* Qg = (const bf16*)(a.ws + WS_Q) + (size_t)b * SEQ * DM + hd * 128;
    const bf16* GB = (const bf16*)(a.ws + WS_GB) + (size_t)b * SEQ * DM + hd * 128;
    bf16* OD = (bf16*)(a.ws + (dir ? WS_OB : WS_OF)) + (size_t)b * SEQ * DM + hd * 128;
    bf16* Y = (bf16*)(a.ws + WS_Y) + (size_t)b * SEQ * DMIX + DM + hd * 128;
    const int pc = vs * 32 + l31;
    const int tg = tid & 255, vrow = tg >> 3, vpc = tg & 7;
    const int vslot = hg_slot(vrow);
    const int nsteps = J.n_ctx + J.n_lat;
    const int nfold = dir ? J.nfold1 : J.nfold0;
    float* outS = dir ? J.outS1 : J.outS0;
    float* outD = dir ? J.outD1 : J.outD0;

    f32x16 S[4];
#pragma unroll
    for (int kt = 0; kt < 4; ++kt)
#pragma unroll
        for (int i = 0; i < 16; ++i) S[kt][i] = 0.f;
    {
        const float* pS = J.foldS + ((size_t)(dir * 8) * 4 + vs) * 4096 + lane;
        const float* pD = J.foldD + (size_t)(dir * 8) * 256;
        f32x16 PA[4], PB[4];
#define HG_FLOAD(P, k) do { const float* p_ = pS + (size_t)(k) * 16384; _Pragma("unroll") for (int kt = 0; kt < 4; ++kt) _Pragma("unroll") for (int i = 0; i < 16; ++i) P[kt][i] = p_[(kt * 16 + i) * 64]; } while (0)
#define HG_FFOLD(P, k) do { const float* d_ = pD + (size_t)(k) * 256; _Pragma("unroll") for (int kt = 0; kt < 4; ++kt) _Pragma("unroll") for (int g = 0; g < 4; ++g) { \
            const f32x4 d0 = *(const f32x4*)(d_ + kt * 32 + 8 * g + 4 * h); \
            S[kt][4 * g + 0] = S[kt][4 * g + 0] * d0.x + P[kt][4 * g + 0]; S[kt][4 * g + 1] = S[kt][4 * g + 1] * d0.y + P[kt][4 * g + 1]; \
            S[kt][4 * g + 2] = S[kt][4 * g + 2] * d0.z + P[kt][4 * g + 2]; S[kt][4 * g + 3] = S[kt][4 * g + 3] * d0.w + P[kt][4 * g + 3]; } } while (0)
        for (int k = 0; k < nfold; ++k) { HG_FLOAD(PA, k); HG_FFOLD(PA, k); }
#undef HG_FLOAD
#undef HG_FFOLD
    }
    if (h == 1) { ((LAS float*)(L + HG_RL))[128 + pc] = 1.0f; }
    float dprod = 1.0f;

    v4u vr0, vr1;
#define HG_BASE(i) ((i) < J.n_ctx ? (dir ? (224 - 32 * (i)) : 32 * (i)) : CTXL + 32 * (dir ? (J.jcb - ((i) - J.n_ctx)) : (J.jcf + ((i) - J.n_ctx))))
#define HG_LOADV(i) do { const int _base = HG_BASE(i); const int mrow = _base + (dir ? 31 - vrow : vrow); \
        const v4u* vp = (const v4u*)(Vg + (size_t)mrow * DM + vpc * 16); vr0 = vp[0]; vr1 = vp[1]; } while (0)
#define HG_DMA_RAW(i) do { const int _base = HG_BASE(i); const bool _lq = ((i) >= J.n_ctx) && J.output; \
        _Pragma("unroll") for (int k2 = 0; k2 < 2; ++k2) { const int slot = 8 * vs + 4 * k2 + (lane >> 4), tok = hg_slot(slot), mrow = _base + (dir ? 31 - tok : tok); \
            __builtin_amdgcn_global_load_lds((const unsigned*)(Fg + (size_t)mrow * DM + (lane & 15) * 8), (LAS unsigned*)(L + HG_RF + (8 * vs + 4 * k2) * HG_RROW), 16, 0, 0); \
            if (_lq) __builtin_amdgcn_global_load_lds((const unsigned*)(Qg + (size_t)(mrow - CTXL) * DM + (lane & 15) * 8), (LAS unsigned*)(L + HG_RQ + (8 * vs + 4 * k2) * HG_RROW), 16, 0, 0); } } while (0)
    HG_LOADV(0);
    HG_DMA_RAW(0);
    VM_WAIT();
    __syncthreads();
    for (int step = 0; step < nsteps; ++step) {
        const bool lat = step >= J.n_ctx;
        const bool outp = lat && J.output;
        const int base = HG_BASE(step);
        {
            *(LAS v4u*)(L + HG_VT + vslot * HG_VROW + vpc * 32) = vr0;
            *(LAS v4u*)(L + HG_VT + vslot * HG_VROW + vpc * 32 + 16) = vr1;
            const LAS unsigned char* rf = L + HG_RF + (16 * h) * HG_RROW + pc * 2;
            const LAS unsigned char* rq = L + HG_RQ + (16 * h) * HG_RROW + pc * 2;
            LAS unsigned char* wq = L + HG_QT + (16 * h) * HG_QROW + pc * 2;
            LAS unsigned char* wk = L + HG_KT + (16 * h) * HG_KROW + pc * 2;
            float X = 1.0f, IX = 1.0f;
#pragma unroll
            for (int jj = 0; jj < 16; ++jj) {
                const float kk = bf2f(*(const LAS unsigned short*)(rf + jj * HG_RROW));
                const float f = 1.0f - kk;
                const float Xn = X * f, IXn = IX * __builtin_amdgcn_rcpf(f);
                const float kt_ = kk * (h ? IXn : X);
                *(LAS unsigned short*)(wk + jj * HG_KROW) = (unsigned short)f2bf(kt_);
                if (outp) {
                    const float q = bf2f(*(const LAS unsigned short*)(rq + jj * HG_RROW));
                    *(LAS unsigned short*)(wq + jj * HG_QROW) = (unsigned short)f2bf(q * (h ? Xn : IX));
                }
                X = Xn; IX = IXn;
            }
            dprod *= X;
            if (h == 0) { const float rlp = ((LAS float*)(L + HG_RL))[((step + 1) & 1) * 128 + pc]; ((LAS float*)(L + HG_FAC))[pc] = X * rlp; }
            else ((LAS float*)(L + HG_RL))[(step & 1) * 128 + pc] = X;
        }
        if (step + 1 < nsteps) HG_LOADV(step + 1);
        __syncthreads();
        if (step + 1 < nsteps) HG_DMA_RAW(step + 1);
        {
            const LAS float* FAC = (const LAS float*)(L + HG_FAC);
#pragma unroll
            for (int kt = 0; kt < 4; ++kt)
#pragma unroll
                for (int g = 0; g < 4; ++g) { const f32x4 fv = *(const LAS f32x4*)(FAC + kt * 32 + 8 * g + 4 * h);
                    S[kt][4 * g + 0] *= fv.x; S[kt][4 * g + 1] *= fv.y; S[kt][4 * g + 2] *= fv.z; S[kt][4 * g + 3] *= fv.w; }
            __builtin_amdgcn_sched_barrier(0);
            s16x8 Vf[2];
#pragma unroll
            for (int sp = 0; sp < 2; ++sp) {
                const LAS unsigned char* p0 = L + HG_VT + (16 * sp + 4 * h + (i16 >> 2)) * HG_VROW + (vs * 32 + 16 * gidx + 4 * (i16 & 3)) * 2;
                Vf[sp] = cat8(ldtr(p0), ldtr(p0 + 8 * HG_VROW));
            }
            if (outp) {
                f32x16 o, P;
#pragma unroll
                for (int i = 0; i < 16; ++i) { o[i] = 0.f; P[i] = 0.f; }
#pragma unroll
                for (int kt = 0; kt < 4; ++kt) {
                    const LAS unsigned char* qp = L + HG_QT + l31 * HG_QROW + (kt * 32 + 4 * h) * 2;
                    const LAS unsigned char* kp = L + HG_KT + l31 * HG_KROW + (kt * 32 + 4 * h) * 2;
                    const s16x8 Qf0 = cat8(*(const LAS s16x4*)(qp), *(const LAS s16x4*)(qp + 16));
                    const s16x8 Qf1 = cat8(*(const LAS s16x4*)(qp + 32), *(const LAS s16x4*)(qp + 48));
                    const s16x8 Kf0 = cat8(*(const LAS s16x4*)(kp), *(const LAS s16x4*)(kp + 16));
                    const s16x8 Kf1 = cat8(*(const LAS s16x4*)(kp + 32), *(const LAS s16x4*)(kp + 48));
                    o = MFMA32(pack8<0>(S[kt]), Qf0, o);
                    o = MFMA32(pack8<1>(S[kt]), Qf1, o);
                    P = MFMA32(Kf0, Qf0, P);
                    P = MFMA32(Kf1, Qf1, P);
                    __builtin_amdgcn_sched_barrier(0);
                }
                const int tb = hg_slot(l31);
#pragma unroll
                for (int i = 0; i < 16; ++i) { const int ta = (i < 8) ? 15 - crow(i, h) : crow(i, h); if (ta > tb) P[i] = 0.f; }
                o = MFMA32(Vf[0], pack8<0>(P), o);
                o = MFMA32(Vf[1], pack8<1>(P), o);
                LAS float* OST = (LAS float*)(L + HG_OST);
#pragma unroll
                for (int g = 0; g < 4; ++g) *(LAS f32x4*)(OST + l31 * HG_OROW + vs * 32 + 8 * g + 4 * h) = (f32x4){o[4 * g], o[4 * g + 1], o[4 * g + 2], o[4 * g + 3]};
            }
#pragma unroll
            for (int kt = 0; kt < 4; ++kt) {
#pragma unroll
                for (int sp = 0; sp < 2; ++sp) {
                    const LAS unsigned char* p0 = L + HG_KT + (16 * sp + 4 * h + (i16 >> 2)) * HG_KROW + (kt * 32 + 16 * gidx + 4 * (i16 & 3)) * 2;
                    const s16x8 KTf = cat8(ldtr(p0), ldtr(p0 + 8 * HG_KROW));
                    S[kt] = MFMA32(KTf, Vf[sp], S[kt]);
                }
            }
        }
        VM_WAIT();
        __syncthreads();
        if (outp) {
            const LAS float* OST = (const LAS float*)(L + HG_OST);
            const int sl = vs * 8 + (lane >> 3), r = hg_slot(sl), pce = lane & 7;
            const int j = base + (dir ? 31 - r : r) - CTXL;
            const LAS float* op = OST + sl * HG_OROW + 16 * pce;
            const f32x4 o0 = *(const LAS f32x4*)(op), o1 = *(const LAS f32x4*)(op + 4), o2 = *(const LAS f32x4*)(op + 8), o3 = *(const LAS f32x4*)(op + 12);
            v4u w0, w1;
            w0.x = cvtpk(o0.x, o0.y); w0.y = cvtpk(o0.z, o0.w); w0.z = cvtpk(o1.x, o1.y); w0.w = cvtpk(o1.z, o1.w);
            w1.x = cvtpk(o2.x, o2.y); w1.y = cvtpk(o2.z, o2.w); w1.z = cvtpk(o3.x, o3.y); w1.w = cvtpk(o3.z, o3.w);
            v4u* dp = (v4u*)(OD + (size_t)j * DM + 16 * pce);
            dp[0] = w0; dp[1] = w1;
        }
    }
#undef HG_LOADV
#undef HG_BASE
#undef HG_DMA_RAW
    if (outS) {
        const LAS float* RLl = (const LAS float*)(L + HG_RL) + ((nsteps - 1) & 1) * 128;
        float* p = outS + (size_t)vs * 4096 + lane;
#pragma unroll
        for (int kt = 0; kt < 4; ++kt)
#pragma unroll
            for (int i = 0; i < 16; ++i) p[(kt * 16 + i) * 64] = S[kt][i] * RLl[kt * 32 + crow(i, h)];
    }
    if (outD) { const float dp2 = dprod * __shfl_xor(dprod, 32); if (h == 0) outD[pc] = dp2; }
    VM_WAIT();
    __syncthreads();
    if (J.output) {
        const bf16* OFp = (const bf16*)(a.ws + WS_OF) + (size_t)b * SEQ * DM + hd * 128;
        const bf16* OBp = (const bf16*)(a.ws + WS_OB) + (size_t)b * SEQ * DM + hd * 128;
        const int pce = tid & 15, j0 = 32 * J.jcf + (tid >> 4);
        const f32x4 nwa = *(const f32x4*)(a.in[I_HNW] + 8 * pce), nwb = *(const f32x4*)(a.in[I_HNW] + 8 * pce + 4);
        const int nrows = 32 * J.n_lat;
#pragma unroll 4
        for (int q = 0; q < nrows; q += 32) {
            const int j = j0 + q, t = ((j & 63) << 6) | (j >> 6);
            const v4u xf = *(const v4u*)(OFp + (size_t)j * DM + 8 * pce), xb = *(const v4u*)(OBp + (size_t)j * DM + 8 * pce), gv = *(const v4u*)(GB + (size_t)t * DM + 8 * pce);
            float o[8];
            o[0] = __builtin_bit_cast(float, xf.x << 16) + __builtin_bit_cast(float, xb.x << 16); o[1] = __builtin_bit_cast(float, xf.x & 0xffff0000u) + __builtin_bit_cast(float, xb.x & 0xffff0000u);
            o[2] = __builtin_bit_cast(float, xf.y << 16) + __builtin_bit_cast(float, xb.y << 16); o[3] = __builtin_bit_cast(float, xf.y & 0xffff0000u) + __builtin_bit_cast(float, xb.y & 0xffff0000u);
            o[4] = __builtin_bit_cast(float, xf.z << 16) + __builtin_bit_cast(float, xb.z << 16); o[5] = __builtin_bit_cast(float, xf.z & 0xffff0000u) + __builtin_bit_cast(float, xb.z & 0xffff0000u);
            o[6] = __builtin_bit_cast(float, xf.w << 16) + __builtin_bit_cast(float, xb.w << 16); o[7] = __builtin_bit_cast(float, xf.w & 0xffff0000u) + __builtin_bit_cast(float, xb.w & 0xffff0000u);
            float ss = (o[0] * o[0] + o[1] * o[1]) + (o[2] * o[2] + o[3] * o[3]) + (o[4] * o[4] + o[5] * o[5]) + (o[6] * o[6] + o[7] * o[7]);
            ss += __shfl_xor(ss, 1); ss += __shfl_xor(ss, 2); ss += __shfl_xor(ss, 4); ss += __shfl_xor(ss, 8);
            const float rs = 1.0f / sqrtf(ss * (1.0f / 128.0f) + EPS);
            v4u w;
            w.x = cvtpk(o[0] * rs * nwa.x * __builtin_bit_cast(float, gv.x << 16), o[1] * rs * nwa.y * __builtin_bit_cast(float, gv.x & 0xffff0000u));
            w.y = cvtpk(o[2] * rs * nwa.z * __builtin_bit_cast(float, gv.y << 16), o[3] * rs * nwa.w * __builtin_bit_cast(float, gv.y & 0xffff0000u));
            w.z = cvtpk(o[4] * rs * nwb.x * __builtin_bit_cast(float, gv.z << 16), o[5] * rs * nwb.y * __builtin_bit_cast(float, gv.z & 0xffff0000u));
            w.w = cvtpk(o[6] * rs * nwb.z * __builtin_bit_cast(float, gv.w << 16), o[7] * rs * nwb.w * __builtin_bit_cast(float, gv.w & 0xffff0000u));
            *(v4u*)(Y + (size_t)t * DMIX + 8 * pce) = w;
        }
        __syncthreads();
    }
}

constexpr int RG_UROW = 272;
constexpr int RG_U = 0, RG_XR = 17408, RG_CW = 35840, RG_LDS = 38400;
struct RglruJob {
    int b, n;
    int tf, nf;
    int tb, nb;
    int pass2;
    int nfold0, nfold1;
    float* aggF; float* aggB;
    const float* agg0;
};

__device__ __forceinline__ void rglru_run(const Args& a, const RglruJob& J, LAS unsigned char* lds) {
    const int tid = threadIdx.x, lane = tid & 63, wave = __builtin_amdgcn_readfirstlane(tid >> 6);
    const int dir = wave >> 2, cq = wave & 3, h = lane >> 5, l31 = lane & 31;
    const int b = J.b, n = J.n;
    const int ch = n * 128 + cq * 32 + l31;
    const bf16* XA = (const bf16*)(a.ws + WS_XA) + (size_t)b * TT * DM + n * 128;
    const bf16* GA = (const bf16*)(a.ws + WS_GA) + (size_t)b * SEQ * DM + ch;
    bf16* Y = (bf16*)(a.ws + WS_Y) + (size_t)b * SEQ * DMIX + ch;
    LAS unsigned char* U = lds + RG_U + dir * (32 * RG_UROW);
    LAS unsigned char* XR = lds + RG_XR + dir * 9216;
    LAS float* CW = (LAS float*)(lds + RG_CW);
    if (tid < 128) {
#pragma unroll
        for (int k = 0; k < 4; ++k) CW[k * 128 + tid] = a.in[I_CONVW][k * DM + n * 128 + tid];
        CW[512 + tid] = a.in[I_CONVB][n * 128 + tid];
    }
    const int t0 = dir ? J.tb : J.tf, tstep = dir ? -1 : 1, nmine = dir ? J.nb : J.nf;
    const int nsteps = J.nf > J.nb ? J.nf : J.nb;
#define RG_DMA(gt) do { _Pragma("unroll") for (int k3 = 0; k3 < 3; ++k3) { const int pcs = cq + 4 * k3; if (pcs < 9) { int row = 32 * (gt) - 2 + 4 * pcs + (lane >> 4); row = row < 0 ? 0 : (row > TT - 1 ? TT - 1 : row); \
        __builtin_amdgcn_global_load_lds((const unsigned*)(XA + (size_t)row * DM + (lane & 15) * 8), (LAS unsigned*)(XR + pcs * 1024), 16, 0, 0); } } } while (0)
    if (nmine > 0) RG_DMA(t0);
    s16x8 Br[8], Bi[8];
    {
        const bf16* Wt = (const bf16*)(a.ws + WS_LRUW);
        const bf16* wr = Wt + ((size_t)((dir * 2 + 0) * 16 + n) * 128 + cq * 32 + l31) * 128 + 8 * h;
        const bf16* wi = Wt + ((size_t)((dir * 2 + 1) * 16 + n) * 128 + cq * 32 + l31) * 128 + 8 * h;
#pragma unroll
        for (int ks = 0; ks < 8; ++ks) { Br[ks] = *(const s16x8*)(wr + 16 * ks); Bi[ks] = *(const s16x8*)(wi + 16 * ks); }
    }
    const float br_ = -1.4426950408889634f * a.in[I_BR][dir * DM + ch], bi_ = -1.4426950408889634f * a.in[I_BI][dir * DM + ch];
    const float lam = a.in[I_LAM][dir * DM + ch];
    const float sp = (-lam > 20.f) ? -lam : log1pf(__expf(-lam));
    const float cch2 = -8.0f * sp * 1.4426950408889634f;
    float carry = 0.f, Aseg = 1.f;
    if (J.pass2) {
        const int nfo = dir ? J.nfold1 : J.nfold0;
        const float* ag = J.agg0 + (size_t)dir * 9 * 256 + cq * 32 + l31;
        float av[9], bv[9];
#pragma unroll
        for (int k = 0; k < 9; ++k) { const int ke = k < nfo ? k : 0; av[k] = ag[ke * 256]; bv[k] = ag[ke * 256 + 128]; }
#pragma unroll
        for (int k = 0; k < 9; ++k) carry = (k < nfo) ? av[k] * carry + bv[k] : carry;
    }
    const int tg = tid & 255, tk0 = tg >> 4, pp = tg & 15;
    const int srow = 16 * ((l31 >> 2) & 1) + 4 * (l31 >> 3) + (l31 & 3);
    VM_WAIT();
    __syncthreads();
    for (int step = 0; step < nsteps; ++step) {
        const bool act = step < nmine;
        const int gt = t0 + tstep * step;
        const bool second = J.pass2 && (step >= (nsteps >> 1));
        unsigned short hp[16], gp[16];
        if (act) {
            const int lo = gt < 8 ? 0 : CTXL, hi = gt < 8 ? CTXL : TT;
#pragma unroll
            for (int q2 = 0; q2 < 2; ++q2) {
                const int tk = tk0 + 16 * q2, mrow = 32 * gt + tk;
                float u[8];
                { const f32x4 c0 = *(const LAS f32x4*)(CW + 512 + 8 * pp), c1 = *(const LAS f32x4*)(CW + 512 + 8 * pp + 4);
                  u[0] = c0.x; u[1] = c0.y; u[2] = c0.z; u[3] = c0.w; u[4] = c1.x; u[5] = c1.y; u[6] = c1.z; u[7] = c1.w; }
#pragma unroll
                for (int k = 0; k < 4; ++k) {
                    const int rr = mrow + k - 2;
                    const float m = (rr >= lo && rr < hi) ? 1.0f : 0.0f;
                    const v4u xv = *(const LAS v4u*)(XR + (tk + k) * 256 + 16 * pp);
                    const f32x4 w0 = *(const LAS f32x4*)(CW + k * 128 + 8 * pp) * m, w1 = *(const LAS f32x4*)(CW + k * 128 + 8 * pp + 4) * m;
                    u[0] += __builtin_bit_cast(float, xv.x << 16) * w0.x; u[1] += __builtin_bit_cast(float, xv.x & 0xffff0000u) * w0.y;
                    u[2] += __builtin_bit_cast(float, xv.y << 16) * w0.z; u[3] += __builtin_bit_cast(float, xv.y & 0xffff0000u) * w0.w;
                    u[4] += __builtin_bit_cast(float, xv.z << 16) * w1.x; u[5] += __builtin_bit_cast(float, xv.z & 0xffff0000u) * w1.y;
                    u[6] += __builtin_bit_cast(float, xv.w << 16) * w1.z; u[7] += __builtin_bit_cast(float, xv.w & 0xffff0000u) * w1.w;
                }
                v4u o; o.x = cvtpk(u[0], u[1]); o.y = cvtpk(u[2], u[3]); o.z = cvtpk(u[4], u[5]); o.w = cvtpk(u[6], u[7]);
                const int sidx = dir ? 31 - tk : tk;
                *(LAS v4u*)(U + sidx * RG_UROW + 16 * pp) = o;
            }
            if (second) {
                const int tl = 32 * (gt - 8) + (dir ? 31 - 16 * h : 16 * h);
#pragma unroll
                for (int i = 0; i < 16; ++i) { const int t = tl + (dir ? -i : i); hp[i] = Y[(size_t)t * DMIX]; gp[i] = GA[(size_t)t * DM]; }
            }
        }
        __syncthreads();
        if (step + 1 < nmine) RG_DMA(gt + tstep);
        if (act) {
            f32x16 zr, zi;
#pragma unroll
            for (int i = 0; i < 16; ++i) { zr[i] = br_; zi[i] = bi_; }
            {
                const LAS unsigned char* ap = U + srow * RG_UROW + 16 * h;
#pragma unroll
                for (int ks = 0; ks < 8; ++ks) { const s16x8 af = *(const LAS s16x8*)(ap + 32 * ks);
                    zr = MFMA32(af, Br[ks], zr); zi = MFMA32(af, Bi[ks], zi); }
            }
            float hl[16], Pp[16];
            {
                const LAS unsigned char* up = U + (16 * h) * RG_UROW + (cq * 32 + l31) * 2;
                float hrun = 0.f, prun = 1.f;
#pragma unroll
                for (int i = 0; i < 16; ++i) {
                    const float r = __builtin_amdgcn_rcpf(1.0f + __builtin_amdgcn_exp2f(zr[i]));
                    const float ig = __builtin_amdgcn_rcpf(1.0f + __builtin_amdgcn_exp2f(zi[i]));
                    const float av = __builtin_amdgcn_exp2f(cch2 * r);
                    const float uu = bf2f(*(const LAS unsigned short*)(up + i * RG_UROW));
                    const float bx = __builtin_amdgcn_sqrtf(fmaxf(1.0f - av * av, 0.f)) * (ig * uu);
                    hrun = av * hrun + bx; prun *= av;
                    hl[i] = hrun; Pp[i] = prun;
                }
            }
            const float pO = __shfl_xor(Pp[15], 32), hO = __shfl_xor(hl[15], 32);
            const float e0 = h ? (hO + pO * carry) : (hl[15] + Pp[15] * carry);
            const float start = h ? e0 : carry;
            const float cout = h ? (hl[15] + Pp[15] * e0) : (hO + pO * e0);
            if (J.pass2) {
                const int tl = 32 * (gt - 8) + (dir ? 31 - 16 * h : 16 * h);
                if (!second) {
#pragma unroll
                    for (int i = 0; i < 16; ++i) { const int t = tl + (dir ? -i : i); Y[(size_t)t * DMIX] = (bf16)f2bf(hl[i] + Pp[i] * start); }
                } else {
#pragma unroll
                    for (int i = 0; i < 16; ++i) { const int t = tl + (dir ? -i : i);
                        Y[(size_t)t * DMIX] = (bf16)f2bf((hl[i] + Pp[i] * start + bf2f(hp[i])) * bf2f(gp[i])); }
                }
            } else Aseg *= pO * Pp[15];
            carry = cout;
        }
        VM_WAIT();
        __syncthreads();
    }
#undef RG_DMA
    if (!J.pass2) {
        float* ag = dir ? J.aggB : J.aggF;
        if (h == 0 && ag) { ag[cq * 32 + l31] = Aseg; ag[128 + cq * 32 + l31] = carry; }
    }
    __syncthreads();
}

__global__ void __launch_bounds__(NTHR, 2) fwd_kernel(Args args) {
    extern __shared__ __attribute__((aligned(16))) unsigned char lds_raw[];
    LAS unsigned char* lds = (LAS unsigned char*)lds_raw;
    volatile LAS unsigned* MISC = (volatile LAS unsigned*)(lds + MISC_OFF);
    const int tid = threadIdx.x, lane = tid & 63, wave = __builtin_amdgcn_readfirstlane(tid >> 6);
    const int G = gridDim.x, bx = blockIdx.x;
    unsigned char* ws = args.ws;
    unsigned* ctl = (unsigned*)(ws + WS_CTL);
    for (int u = tid; u < (LDS_BYTES - LDSCTL_OFF) / 4; u += NTHR) ((LAS unsigned*)(lds + LDSCTL_OFF))[u] = 0u;
    __syncthreads();
    const int lo = args.ph_lo, hi = args.ph_hi;
    const bool fused = (hi - lo) > 1;
    XcdBarrier bar; bar.bar = ctl + CW_BAR; bar.x = 0; bar.st = nullptr;
    if (fused) bar = xcd_barrier_post(ctl + CW_BAR, MISC + 8);
#define IN(k) (lo <= (k) && (k) < hi)
#define BOTH(k) (IN(k) && IN((k) + 1))
#define GRID_BAR() xcd_barrier(bar)

    float* MOD = (float*)(ws + WS_MOD);
    bf16* WIN_T = (bf16*)(ws + WS_WIN); bf16* WOUT_T = (bf16*)(ws + WS_WOUT); bf16* H = (bf16*)(ws + WS_H);

    if (IN(0)) {
        LAS float* SC = (LAS float*)lds;
        LAS float* RED = (LAS float*)(lds + 24576);
        bool sc_ready = false;
        for (int item = bx; item < 192; item += G) {
            if (!sc_ready) {
                for (int i = tid; i < 3 * DM; i += NTHR) { const int v = i / DM, k = i % DM; const float cv = (v < 2) ? args.in[I_C][v * DM + k] : args.in[I_CCTX][k]; SC[i] = siluf_(cv); }
                sc_ready = true;
            }
            __syncthreads();
            float acc[3][4];
#pragma unroll
            for (int v = 0; v < 3; ++v)
#pragma unroll
                for (int e = 0; e < 4; ++e) acc[v][e] = 0.f;
            const float* Wp = args.in[I_ADAW] + (size_t)(wave * 256 + (lane >> 3)) * 6144 + item * 32 + 4 * (lane & 7);
#pragma unroll 8
            for (int it = 0; it < 32; ++it) {
                const f32x4 wv = *(const f32x4*)(Wp + (size_t)it * 8 * 6144);
                const int k = wave * 256 + it * 8 + (lane >> 3);
#pragma unroll
                for (int v = 0; v < 3; ++v) { const float s = SC[v * DM + k];
#pragma unroll
                    for (int e = 0; e < 4; ++e) acc[v][e] += s * wv[e]; }
            }
#pragma unroll
            for (int v = 0; v < 3; ++v)
#pragma unroll
                for (int e = 0; e < 4; ++e) { float x = acc[v][e]; x += __shfl_xor(x, 8); x += __shfl_xor(x, 16); x += __shfl_xor(x, 32); acc[v][e] = x; }
            if (lane < 8) {
#pragma unroll
                for (int v = 0; v < 3; ++v)
#pragma unroll
                    for (int e = 0; e < 4; ++e) RED[(wave * 3 + v) * 32 + 4 * lane + e] = acc[v][e];
            }
            __syncthreads();
            if (tid < 96) { const int v = tid >> 5, col = tid & 31; float s = args.in[I_ADAB][item * 32 + col];
#pragma unroll
                for (int w = 0; w < 8; ++w) s += RED[(w * 3 + v) * 32 + col];
                MOD[v * 6144 + item * 32 + col] = s; }
            __syncthreads();
        }
        __syncthreads();
        if (bx == G - 1) { float* OMLp = (float*)(ws + WS_OML);
            for (int i = tid; i < 2 * DM; i += NTHR) { const int d_ = i / DM, c_ = i % DM;
                OMLp[i] = 1.0f - sigmoidf_(args.in[I_LB][(d_ * 2 + 0) * DM + c_] - args.in[I_LB][(d_ * 2 + 1) * DM + c_]); } }
        LAS float* scr = (LAS float*)(lds + wave * 16384);
        const int gw = bx * NWAVES + wave, NGW = G * NWAVES;
        constexpr int I_1 = (DM / 64) * (INC / 32), I_2 = (DMIX / 64) * (DM / 32), I_3 = 64 * 8;
        for (int it = gw; it < I_1 + I_2 + I_3; it += NGW) {
            if (it < I_1) p0_transpose_item(args.in[I_WIN], DM, INC, WIN_T, scr, it, lane);
            else if (it < I_1 + I_2) p0_transpose_item(args.in[I_WOUT], DMIX, DM, WOUT_T, scr, it - I_1, lane);
            else { const int r = it - I_1 - I_2, m = r >> 3, sub = r & 7, dirn = m >> 1, gate = m & 1;
                p0_transpose_item((gate ? args.in[I_WI] : args.in[I_WR]) + (size_t)dirn * 16384, 128, 128,
                                  (bf16*)(ws + WS_LRUW) + ((size_t)(((dirn >> 4) * 2 + gate) * 16 + (dirn & 15))) * 16384, scr, sub, lane, -1.4426950408889634f); }
        }
        if (BOTH(0)) GRID_BAR();
    }

    if (IN(1)) {
        const int gw = bx * NWAVES + wave, NGW = G * NWAVES;
        for (int R = gw; R < MTOT; R += NGW) {
            const float* src; int mv;
            if (R < MLAT) { src = args.in[I_X] + (size_t)R * DM; mv = R >> 12; } else { src = args.in[I_CTX] + (size_t)(R - MLAT) * DM; mv = 2; }
            const float* shift = MOD + mv * 6144; const float* scale = shift + DM;
            f32x4 v[8]; float ss = 0.f;
#pragma unroll
            for (int j = 0; j < 8; ++j) { v[j] = *(const f32x4*)(src + 4 * lane + 256 * j); ss += (v[j].x * v[j].x + v[j].y * v[j].y) + (v[j].z * v[j].z + v[j].w * v[j].w); }
            const float rs = 1.0f / sqrtf(wave_sum(ss) * (1.0f / DM) + EPS);
            bf16* dst = H + (size_t)R * DM;
#pragma unroll
            for (int j = 0; j < 8; ++j) { const int c0 = 4 * lane + 256 * j;
                const f32x4 nw = *(const f32x4*)(args.in[I_NORMW] + c0), sc = *(const f32x4*)(scale + c0), sh = *(const f32x4*)(shift + c0);
                const f32x4 o = (v[j] * rs) * nw * (1.0f + sc) + sh;
                v2u w; w.x = pk2(o.x, o.y); w.y = pk2(o.z, o.w); *(v2u*)(dst + c0) = w; }
        }
        if (BOTH(1)) GRID_BAR();
    }

    if (IN(2)) {
        pg8::Gemm g{H, WIN_T, MTOT, INC, DM}; Order1 S{G, bx};
        Epi1 E{(bf16*)(ws + WS_XA), (bf16*)(ws + WS_GA), (bf16*)(ws + WS_Q), (bf16*)(ws + WS_FF), (bf16*)(ws + WS_FB), (bf16*)(ws + WS_V), (bf16*)(ws + WS_GB), (const float*)(ws + WS_OML)};
        pg8::gemm_phase<Epi1, Order1, true, true>(lds, g, S, E);
        if (BOTH(2)) GRID_BAR();
    }

    float* HST = (float*)(ws + WS_HST); float* HDD = (float*)(ws + WS_HDD); float* AGG = (float*)(ws + WS_AGG);
    if (IN(3)) {
        for (int item = bx; item < 256; item += G) {
            const int bh = item >> 3, e = item & 7;
            HgrnJob J{}; J.b = bh >> 4; J.hd = bh & 15; J.output = 0;
            if (e == 0) { J.n_ctx = 8; J.n_lat = 0; } else { J.n_ctx = 0; J.n_lat = 16; J.jcf = 16 * (e - 1); J.jcb = 16 * (8 - e) + 15; }
            J.outS0 = HST + ((size_t)(bh * 2 + 0) * 8 + e) * 16384; J.outS1 = HST + ((size_t)(bh * 2 + 1) * 8 + e) * 16384;
            J.outD0 = HDD + ((size_t)(bh * 2 + 0) * 8 + e) * 256; J.outD1 = HDD + ((size_t)(bh * 2 + 1) * 8 + e) * 256;
            hgrn_run(args, J, lds);
        }
    }
    if (IN(4)) {
        for (int item = bx; item < 256; item += G) {
            const int bn = item >> 3, c = item & 7;
            RglruJob J{}; J.b = bn >> 4; J.n = bn & 15; J.pass2 = 0;
            float* A0 = AGG + (size_t)(bn * 2 + 0) * 9 * 256; float* A1 = AGG + (size_t)(bn * 2 + 1) * 9 * 256;
            if (c < 7) { J.tf = 8 + 16 * c; J.nf = 16; J.aggF = A0 + (1 + c) * 256; } else { J.tf = 0; J.nf = 8; J.aggF = A0; }
            if (c > 0) { J.tb = 8 + 16 * c + 15; J.nb = 16; J.aggB = A1 + (1 + (7 - c)) * 256; } else { J.tb = 7; J.nb = 8; J.aggB = A1; }
            rglru_run(args, J, lds);
        }
        if (BOTH(4)) GRID_BAR();
    }

    if (IN(5)) {
        for (int item = bx; item < 256; item += G) {
            const int bh = item >> 3, g = item & 7;
            HgrnJob J{}; J.b = bh >> 4; J.hd = bh & 15; J.output = 1; J.n_ctx = 0; J.n_lat = 16; J.jcf = 16 * g; J.jcb = 16 * g + 15;
            J.nfold0 = g + 1; J.nfold1 = 8 - g; J.foldS = HST + (size_t)bh * 2 * 8 * 16384; J.foldD = HDD + (size_t)bh * 2 * 8 * 256;
            hgrn_run(args, J, lds);
        }
    }
    if (IN(6)) {
        for (int item = bx; item < 256; item += G) {
            const int bn = item >> 3, c = item & 7;
            RglruJob J{}; J.b = bn >> 4; J.n = bn & 15; J.pass2 = 1;
            J.tf = 8 + 16 * c; J.nf = 16; J.tb = 8 + 16 * c + 15; J.nb = 16; J.nfold0 = c + 1; J.nfold1 = 8 - c;
            J.agg0 = AGG + (size_t)bn * 2 * 9 * 256;
            rglru_run(args, J, lds);
        }
        if (BOTH(6)) GRID_BAR();
    }

    if (IN(7)) {
        pg8::Gemm g{(const bf16*)(ws + WS_Y), WOUT_T, MLAT, DM, DMIX}; Order2 S{G, bx};
        Epi2 E{args.in[I_X], MOD, args.out};
        pg8::gemm_phase<Epi2, Order2, false, true>(lds, g, S, E);
        if (BOTH(7)) GRID_BAR();
    }

    if (IN(8)) {
        const int gw = bx * NWAVES + wave, NGW = G * NWAVES;
        for (int R = gw; R < MLAT; R += NGW) {
            float* row = args.out + (size_t)R * DM;
            f32x4 v[8]; float ss = 0.f;
#pragma unroll
            for (int j = 0; j < 8; ++j) { v[j] = *(const f32x4*)(row + 4 * lane + 256 * j); ss += (v[j].x * v[j].x + v[j].y * v[j].y) + (v[j].z * v[j].z + v[j].w * v[j].w); }
            const float rs = 1.0f / sqrtf(wave_sum(ss) * (1.0f / DM) + EPS);
#pragma unroll
            for (int j = 0; j < 8; ++j) { const int c0 = 4 * lane + 256 * j; const f32x4 nw = *(const f32x4*)(args.in[I_FNW] + c0);
                *(f32x4*)(row + c0) = (v[j] * rs) * nw; }
        }
    }
#undef IN
#undef BOTH
#undef GRID_BAR
}

extern "C" void kernel_launch(void* const* d_in, const int* in_sizes, int n_in, void* d_out, int out_size, void* d_ws, size_t ws_size, hipStream_t stream) {
    static int grid = 0;
    if (grid == 0) {
        if (n_in != 19 || out_size != MLAT * DM || ws_size < WS_END) { fprintf(stderr, "kernel_launch: unexpected problem shape (n_in %d out %d ws %zu)\n", n_in, out_size, ws_size); grid = -1; return; }
        int dev = 0, cus = 0, per_cu = 0;
        if (hipGetDevice(&dev) != hipSuccess || hipDeviceGetAttribute(&cus, hipDeviceAttributeMultiprocessorCount, dev) != hipSuccess) { grid = -1; return; }
        if (hipFuncSetAttribute((const void*)fwd_kernel, hipFuncAttributeMaxDynamicSharedMemorySize, LDS_BYTES) != hipSuccess) { fprintf(stderr, "kernel_launch: hipFuncSetAttribute failed\n"); grid = -1; return; }
        if (hipOccupancyMaxActiveBlocksPerMultiprocessor(&per_cu, (const void*)fwd_kernel, NTHR, LDS_BYTES) != hipSuccess || per_cu < 1) { fprintf(stderr, "kernel_launch: occupancy query failed (%d)\n", per_cu); grid = -1; (void)hipGetLastError(); return; }
        grid = cus * 1;
    }
    if (grid < 0) return;
    (void)hipMemsetAsync((char*)d_ws + WS_CTL, 0, CTL_ZERO_BYTES, stream);
    Args a{};
    for (int i = 0; i < 19; ++i) a.in[i] = (const float*)d_in[i];
    a.out = (float*)d_out; a.ws = (unsigned char*)d_ws;
#if MK_N_LAUNCHES == 1
    a.ph_lo = 0; a.ph_hi = NPHASE;
    void* kargs[] = {&a};
    hipError_t e = hipLaunchCooperativeKernel((const void*)fwd_kernel, dim3(grid), dim3(NTHR), kargs, LDS_BYTES, stream);
    if (e != hipSuccess) fprintf(stderr, "cooperative launch failed: %s (grid %d)\n", hipGetErrorString(e), grid);
#else
    for (int p = 0; p < NPHASE; ++p) {
        a.ph_lo = p; a.ph_hi = p + 1;
        hipLaunchKernelGGL(fwd_kernel, dim3(grid), dim3(NTHR), LDS_BYTES, stream, a);
        if (p == REP_PHASE) hipLaunchKernelGGL(fwd_kernel, dim3(grid), dim3(NTHR), LDS_BYTES, stream, a);
    }
#endif
}
```
